# Optimizing an MI355X kernel written in HIP

```python
import math
import jax, jax.numpy as jnp
from jax import lax
import numpy as np

D_MODEL = 1024
BATCH = 2
SEQ = 16384
DEPTH = 2

D_FF = 2816
D_MIX = D_MODEL
HEAD_DIM = 64
A_HEADS = 4
A_DIM = A_HEADS * HEAD_DIM
CHUNK = 128
B_GROUPS = 4
B_DIM = B_GROUPS * HEAD_DIM
B_CONV = 3
C_HEADS = 8
C_DIM = C_HEADS * HEAD_DIM
C_CONV = 4
RG_C = 8.0
IN_COLS = 2 * A_DIM + 3 * B_DIM + 2 * C_DIM
ALPHA = (2.0 * DEPTH) ** 0.25
BETA = (8.0 * DEPTH) ** -0.25
LN_EPS = 1e-5

kernel_name = "hybrid_sgu_shortconv_rglru_macaron_deepnorm"


def layer_norm(x, g, b):
    xf = x.astype(jnp.float32)
    mu = jnp.mean(xf, axis=-1, keepdims=True)
    xc = xf - mu
    var = jnp.mean(xc * xc, axis=-1, keepdims=True)
    y = xc * lax.rsqrt(var + LN_EPS) * g.astype(jnp.float32) + b.astype(jnp.float32)
    return y.astype(x.dtype)


def swiglu(x, w_gate, w_up, w_down):
    return (jax.nn.silu(x @ w_gate) * (x @ w_up)) @ w_down


def causal_dwconv(x, w):
    k_width = w.shape[0]
    s = x.shape[1]
    xp = jnp.pad(x, ((0, 0), (k_width - 1, 0), (0, 0)))
    y = xp[:, 0:s] * w[0]
    for k in range(1, k_width):
        y = y + xp[:, k:k + s] * w[k]
    return y


def mixer_spatial_gating(z, ln_g, ln_b, w_s, b_s):
    z = jax.nn.gelu(z)
    u, v = jnp.split(z, 2, axis=-1)
    v = layer_norm(v, ln_g, ln_b)
    bsz, s, _ = v.shape
    vc = v.reshape(bsz, s // CHUNK, CHUNK, A_HEADS, HEAD_DIM)
    mask = jnp.tril(jnp.ones((CHUNK, CHUNK), dtype=bool))
    w = jnp.where(mask[None], w_s, jnp.zeros_like(w_s))
    mixed = jnp.einsum('hts,bnshd->bnthd', w, vc) + b_s.T[None, None, :, :, None]
    return u * mixed.reshape(bsz, s, A_DIM)


def mixer_short_conv(z, conv_w):
    b_gate, c_gate, xin = jnp.split(z, 3, axis=-1)
    return b_gate * causal_dwconv(c_gate * xin, conv_w)


def _lru_combine(left, right):
    a1, b1 = left
    a2, b2 = right
    return a1 * a2, a2 * b1 + b2


def mixer_rglru(z, conv_w, conv_b, w_a, b_a, w_i, b_i, lam):
    gate, xr = jnp.split(z, 2, axis=-1)
    xr = causal_dwconv(xr, conv_w) + conv_b
    bsz, s, _ = xr.shape
    xh = xr.reshape(bsz, s, C_HEADS, HEAD_DIM)
    r = jax.nn.sigmoid(jnp.einsum('bshd,hde->bshe', xh, w_a) + b_a).reshape(bsz, s, C_DIM)
    i = jax.nn.sigmoid(jnp.einsum('bshd,hde->bshe', xh, w_i) + b_i).reshape(bsz, s, C_DIM)
    log_a = -RG_C * r.astype(jnp.float32) * jax.nn.softplus(-lam.astype(jnp.float32))
    a = jnp.exp(log_a)
    mult = jnp.sqrt(jnp.maximum(1.0 - jnp.exp(2.0 * log_a), 0.0))
    bx = mult * (i * xr).astype(jnp.float32)
    _, h = lax.associative_scan(_lru_combine, (a, bx), axis=1)
    return jax.nn.gelu(gate) * h.astype(gate.dtype)


def setup_inputs(seed: int = 0) -> dict:
    key = jax.random.key(seed)
    ks = jax.random.split(key, 24)

    def nrm(k, shape, fan_in, scale=1.0):
        return jax.random.normal(k, shape, jnp.float32) * (scale * fan_in ** -0.5)

    x = jax.random.normal(ks[0], (BATCH, SEQ, D_MODEL), jnp.float32)
    ln_g = 1.0 + 0.02 * jax.random.normal(ks[1], (DEPTH, 3, D_MODEL), jnp.float32)
    ln_b = 0.02 * jax.random.normal(ks[2], (DEPTH, 3, D_MODEL), jnp.float32)
    ffn_w_gate = nrm(ks[3], (DEPTH, 2, D_MODEL, D_FF), D_MODEL)
    ffn_w_up = nrm(ks[4], (DEPTH, 2, D_MODEL, D_FF), D_MODEL)
    ffn_w_down = nrm(ks[5], (DEPTH, 2, D_FF, D_MODEL), D_FF, BETA)
    w_in = nrm(ks[6], (DEPTH, D_MODEL, IN_COLS), D_MODEL)
    sgu_ln_g = 1.0 + 0.02 * jax.random.normal(ks[7], (DEPTH, A_DIM), jnp.float32)
    sgu_ln_b = 0.02 * jax.random.normal(ks[8], (DEPTH, A_DIM), jnp.float32)
    sgu_w = nrm(ks[9], (DEPTH, A_HEADS, CHUNK, CHUNK), CHUNK)
    sgu_b = 1.0 + 0.02 * jax.random.normal(ks[10], (DEPTH, A_HEADS, CHUNK), jnp.float32)
    sconv_w = nrm(ks[11], (DEPTH, B_CONV, B_DIM), B_CONV)
    rg_conv_w = nrm(ks[12], (DEPTH, C_CONV, C_DIM), C_CONV)
    rg_conv_b = 0.02 * jax.random.normal(ks[13], (DEPTH, C_DIM), jnp.float32)
    rg_w_a = nrm(ks[14], (DEPTH, C_HEADS, HEAD_DIM, HEAD_DIM), HEAD_DIM)
    rg_b_a = 0.02 * jax.random.normal(ks[15], (DEPTH, C_HEADS, HEAD_DIM), jnp.float32)
    rg_w_i = nrm(ks[16], (DEPTH, C_HEADS, HEAD_DIM, HEAD_DIM), HEAD_DIM)
    rg_b_i = 0.02 * jax.random.normal(ks[17], (DEPTH, C_HEADS, HEAD_DIM), jnp.float32)
    u = jax.random.uniform(ks[18], (DEPTH, C_DIM), jnp.float32, minval=0.9, maxval=0.999)
    a0 = u ** (1.0 / RG_C)
    rg_lambda = jnp.log(a0) - jnp.log1p(-a0)
    w_out = nrm(ks[19], (DEPTH, D_MIX, D_MODEL), D_MIX, BETA)
    return {"x": x, "ln_g": ln_g, "ln_b": ln_b, "ffn_w_gate": ffn_w_gate, "ffn_w_up": ffn_w_up,
            "ffn_w_down": ffn_w_down, "w_in": w_in, "sgu_ln_g": sgu_ln_g, "sgu_ln_b": sgu_ln_b,
            "sgu_w": sgu_w, "sgu_b": sgu_b, "sconv_w": sconv_w, "rg_conv_w": rg_conv_w,
            "rg_conv_b": rg_conv_b, "rg_w_a": rg_w_a, "rg_b_a": rg_b_a, "rg_w_i": rg_w_i,
            "rg_b_i": rg_b_i, "rg_lambda": rg_lambda, "w_out": w_out}


def reference(x, ln_g, ln_b, ffn_w_gate, ffn_w_up, ffn_w_down, w_in, sgu_ln_g, sgu_ln_b,
              sgu_w, sgu_b, sconv_w, rg_conv_w, rg_conv_b, rg_w_a, rg_b_a, rg_w_i, rg_b_i,
              rg_lambda, w_out):
    split_a = 2 * A_DIM
    split_b = split_a + 3 * B_DIM
    for l in range(DEPTH):
        f = swiglu(x, ffn_w_gate[l, 0], ffn_w_up[l, 0], ffn_w_down[l, 0])
        x = layer_norm(ALPHA * x + 0.5 * f, ln_g[l, 0], ln_b[l, 0])
        z = x @ w_in[l]
        z_a = z[..., :split_a]
        z_b = z[..., split_a:split_b]
        z_c = z[..., split_b:]
        y_a = mixer_spatial_gating(z_a, sgu_ln_g[l], sgu_ln_b[l], sgu_w[l], sgu_b[l])
        y_b = mixer_short_conv(z_b, sconv_w[l])
        y_c = mixer_rglru(z_c, rg_conv_w[l], rg_conv_b[l], rg_w_a[l], rg_b_a[l],
                          rg_w_i[l], rg_b_i[l], rg_lambda[l])
        y = jnp.concatenate([y_a, y_b, y_c], axis=-1) @ w_out[l]
        x = layer_norm(ALPHA * x + y, ln_g[l, 1], ln_b[l, 1])
        f = swiglu(x, ffn_w_gate[l, 1], ffn_w_up[l, 1], ffn_w_down[l, 1])
        x = layer_norm(ALPHA * x + 0.5 * f, ln_g[l, 2], ln_b[l, 2])
    return x
```

```cpp
#include <hip/hip_runtime.h>
#include <hip/hip_cooperative_groups.h>
#include <cstdio>
namespace cg = cooperative_groups;
namespace pg8 {
#define PG8_LAS __attribute__((address_space(3)))
typedef unsigned short bf16_t;
typedef short bf16x8 __attribute__((ext_vector_type(8)));
typedef float f32x4 __attribute__((ext_vector_type(4)));
typedef unsigned u32x4 __attribute__((ext_vector_type(4)));
constexpr int BM = 256, BK = 64, HALF = 128, HTB = HALF * BK * 2  , STAGE_BYTES = 8 * HTB, NXCD = 8, WGM = 8;

__host__ __device__ __forceinline__ int lds_byte(int r, int c) { const int st = (r >> 4) * 2 + (c >> 5), rr = r & 15, cc = c & 31, ob = rr * 64 + cc * 2; return st * 1024 + (ob ^ (((ob >> 9) & 1) << 5)); }
__host__ __device__ __forceinline__ void stage_rc(int b, int& R, int& C) { const int st = b / 1024, sb = b % 1024, swz = sb ^ (((sb >> 9) & 1) << 5); R = (st >> 1) * 16 + swz / 64; C = (st & 1) * 32 + (swz % 64) / 2; }
__host__ __device__ __forceinline__ int perm32(int rho) { const int n = rho >> 4, i = rho & 15; return 8 * (i >> 2) + 4 * n + (i & 3); }

struct Unit { int pm, pn; };
struct Gemm { const bf16_t* A; const bf16_t* Bt; int M, N, K; };

struct StaticOrder {
    int nM, nN, nwg, G, c;
    __host__ __device__ void init(int M, int N, int G_, int c_) { nM = M / BM; nN = N / BM; nwg = nM * nN; G = G_; c = c_; }
    __host__ __device__ bool next(int i, Unit& u) const {
        const long L = (long)i * G + c; if (L >= nwg) return false;
        int wgid = (int)L; { const int q = nwg / NXCD, r = nwg % NXCD, xcd = wgid % NXCD, off = wgid / NXCD; wgid = (xcd < r ? xcd * (q + 1) : r * (q + 1) + (xcd - r) * q) + off; }
        const int nig = WGM * nN, gid = wgid / nig, fm = gid * WGM, gsz = (nM - fm) < WGM ? (nM - fm) : WGM;
        u.pm = fm + ((wgid % nig) % gsz); u.pn = (wgid % nig) / gsz; return true;
    }
    __device__ __forceinline__ void a_ready(const Unit&) const {}
    __device__ __forceinline__ void done(const Unit&) const {}
};
__device__ __forceinline__ unsigned cvt_pk_bf16(float lo, float hi) { unsigned r; asm volatile("v_cvt_pk_bf16_f32 %0, %1, %2" : "=v"(r) : "v"(lo), "v"(hi)); return r; }
template <class Epi, class Sched, bool STAMP = false>
__device__ __forceinline__ void gemm_phase(PG8_LAS unsigned char* lds, const Gemm g, const Sched& S, const Epi& E, unsigned long long* stamps) {
    const int tid = threadIdx.x, wid = __builtin_amdgcn_readfirstlane(tid >> 6), lane = tid & 63, wr = wid >> 2, wc = wid & 3, fr = lane & 15, fq = lane >> 4;
    const int K = g.K, nt = K / BK;
    int ts_lo = 0, ts_hi = 0, nts = 0; const unsigned long long rt_entry = STAMP ? (unsigned long long)wall_clock64() : 0ull;
#define PG8_STAMP() do { if (STAMP && wid == 0 && nts < 64) { const unsigned long long _c = (unsigned long long)clock64(); \
        ts_lo = (lane == nts) ? (int)(unsigned)_c : ts_lo; ts_hi = (lane == nts) ? (int)(unsigned)(_c >> 32) : ts_hi; ++nts; } } while (0)
    PG8_STAMP();
    unsigned voffA[2], voffB[2];
#pragma unroll
    for (int i = 0; i < 2; ++i) { int R, C; stage_rc(tid * 16 + i * 8192, R, C); const int Rb = Epi::PERM ? ((R & ~31) + perm32(R & 31)) : R;
        voffA[i] = (unsigned)(R * K + C) * 2u; voffB[i] = (unsigned)(Rb * K + C) * 2u; }
    const size_t kstep = (size_t)(BK * 2);
    const size_t hstep = (size_t)HALF * K * 2;
    const size_t tstep = 2 * hstep;
    const unsigned ldsw = (unsigned)wid * 1024u;
    const int aoff = lds_byte(wr * 64 + fr, fq * 8), boff = lds_byte(wc * 32 + fr, fq * 8);
#define PG8_SA(b, h) (((b) * 2 + (h)) * HTB)
#define PG8_SB(b, h) ((4 + (b) * 2 + (h)) * HTB)
#define PG8_STAGE(bufoff, gbase, voff) do { _Pragma("unroll") for (int _i = 0; _i < 2; ++_i) \
        __builtin_amdgcn_global_load_lds((const unsigned*)((const char*)(gbase) + (voff)[_i]), (PG8_LAS unsigned*)(lds + (bufoff) + ldsw + _i * 8192), 16, 0, 0); } while (0)
#define PG8_LDA(dst, b, h) do { _Pragma("unroll") for (int m = 0; m < 4; ++m) _Pragma("unroll") for (int k = 0; k < 2; ++k) dst[m][k] = *(const PG8_LAS bf16x8*)(lds + PG8_SA(b, h) + aoff + m * 2048 + k * 1024); } while (0)
#define PG8_LDB(dst, b, h) do { _Pragma("unroll") for (int n = 0; n < 2; ++n) _Pragma("unroll") for (int k = 0; k < 2; ++k) dst[n][k] = *(const PG8_LAS bf16x8*)(lds + PG8_SB(b, h) + boff + n * 2048 + k * 1024); } while (0)
#define PG8_MMA(ai, bj, At, Bt) do { __builtin_amdgcn_s_setprio(1); _Pragma("unroll") for (int m = 0; m < 4; ++m) _Pragma("unroll") for (int n = 0; n < 2; ++n) _Pragma("unroll") for (int k = 0; k < 2; ++k) \
        acc[ai][bj][m][n] = __builtin_amdgcn_mfma_f32_16x16x32_bf16(Bt[n][k], At[m][k], acc[ai][bj][m][n], 0, 0, 0); __builtin_amdgcn_s_setprio(0); } while (0)
#define PG8_WAIT_V(n) asm volatile("s_waitcnt vmcnt(" #n ")" ::: "memory")
#define PG8_WAIT_L(n) asm volatile("s_waitcnt lgkmcnt(" #n ")" ::: "memory")
#define PG8_BAR __builtin_amdgcn_s_barrier()
#define PG8_SCHED __builtin_amdgcn_sched_barrier(0)
    Unit cur, nxt; int ui = 0;
    if (!S.next(0, cur)) return;
    f32x4 acc[2][2][4][2];
#pragma unroll
    for (int a = 0; a < 2; ++a)
#pragma unroll
        for (int b = 0; b < 2; ++b)
#pragma unroll
            for (int m = 0; m < 4; ++m)
#pragma unroll
                for (int n = 0; n < 2; ++n) acc[a][b][m][n] = (f32x4){0.f, 0.f, 0.f, 0.f};
    bf16x8 At[4][2], B0[2][2], B1[2][2];
    const char* cA = (const char*)g.A + (size_t)cur.pm * tstep; const char* cB = (const char*)g.Bt + (size_t)cur.pn * tstep;
    S.a_ready(cur);
    PG8_STAGE(PG8_SB(0, 0), cB, voffB); PG8_STAGE(PG8_SA(0, 0), cA, voffA); PG8_STAGE(PG8_SB(0, 1), cB + hstep, voffB); PG8_STAGE(PG8_SA(0, 1), cA + hstep, voffA);
    if (wr == 1) PG8_BAR;
    PG8_WAIT_V(4); PG8_BAR;
    PG8_STAGE(PG8_SB(1, 0), cB + kstep, voffB); PG8_STAGE(PG8_SA(1, 0), cA + kstep, voffA); PG8_STAGE(PG8_SB(1, 1), cB + hstep + kstep, voffB);
    PG8_WAIT_V(6); PG8_BAR;
    PG8_STAMP();
    for (;;) {
        const bool has_next = S.next(ui + 1, nxt);
        const char* nA = has_next ? (const char*)g.A + (size_t)nxt.pm * tstep : cA; const char* nB = has_next ? (const char*)g.Bt + (size_t)nxt.pn * tstep : cB;
        for (int t = 0; t < nt; t += 2) {
            const bool last = (t == nt - 2);
            const char* a1 = cA + (size_t)(t + 1) * kstep;
            const char* a2 = last ? nA : cA + (size_t)(t + 2) * kstep; const char* b2 = last ? nB : cB + (size_t)(t + 2) * kstep;
            const char* a3 = a2 + kstep; const char* b3 = b2 + kstep;
            if (last && has_next) S.a_ready(nxt);
            PG8_LDB(B0, 0, 0); PG8_SCHED; PG8_LDA(At, 0, 0); PG8_STAGE(PG8_SA(1, 1), a1 + hstep, voffA);
            PG8_WAIT_L(8); PG8_BAR; PG8_WAIT_L(0); PG8_MMA(0, 0, At, B0); PG8_BAR; PG8_SCHED;
            PG8_LDB(B1, 0, 1); PG8_STAGE(PG8_SB(0, 0), b2, voffB);
            PG8_BAR; PG8_WAIT_L(0); PG8_MMA(0, 1, At, B1); PG8_BAR;
            PG8_LDA(At, 0, 1); PG8_STAGE(PG8_SA(0, 0), a2, voffA);
            PG8_BAR; PG8_WAIT_L(0); PG8_MMA(1, 0, At, B0); PG8_BAR; PG8_SCHED;
            PG8_STAGE(PG8_SB(0, 1), b2 + hstep, voffB);
            PG8_WAIT_V(6); PG8_BAR; PG8_MMA(1, 1, At, B1); PG8_BAR;
            PG8_LDB(B0, 1, 0); PG8_SCHED; PG8_LDA(At, 1, 0); PG8_STAGE(PG8_SA(0, 1), a2 + hstep, voffA);
            PG8_WAIT_L(8); PG8_BAR; PG8_WAIT_L(0); PG8_MMA(0, 0, At, B0); PG8_BAR; PG8_SCHED;
            PG8_LDB(B1, 1, 1); PG8_STAGE(PG8_SB(1, 0), b3, voffB);
            PG8_BAR; PG8_WAIT_L(0); PG8_MMA(0, 1, At, B1); PG8_BAR;
            PG8_LDA(At, 1, 1); PG8_STAGE(PG8_SA(1, 0), a3, voffA);
            PG8_BAR; PG8_WAIT_L(0); PG8_MMA(1, 0, At, B0); PG8_BAR; PG8_SCHED;
            PG8_STAGE(PG8_SB(1, 1), b3 + hstep, voffB);
            PG8_WAIT_V(6); PG8_BAR; PG8_MMA(1, 1, At, B1); PG8_BAR;
        }
        PG8_STAMP();
        if constexpr (!Epi::AFTER_DRAIN) { E(acc, cur, wr, wc, fr, fq); S.done(cur); }
        PG8_STAMP();
        if (!has_next) break;
#pragma unroll
        for (int a = 0; a < 2; ++a)
#pragma unroll
            for (int b = 0; b < 2; ++b)
#pragma unroll
                for (int m = 0; m < 4; ++m)
#pragma unroll
                    for (int n = 0; n < 2; ++n) acc[a][b][m][n] = (f32x4){0.f, 0.f, 0.f, 0.f};
        cur = nxt; cA = nA; cB = nB; ++ui;
    }
    PG8_WAIT_V(0);
    if (wr == 0) PG8_BAR;
    PG8_BAR;
    if constexpr (Epi::AFTER_DRAIN) { E.fused(acc, cur, wr, wc, fr, fq, lds, wid, lane); S.done(cur); }
    PG8_STAMP();
    if (STAMP && wid == 0) { stamps[lane] = lane < nts ? (((unsigned long long)(unsigned)ts_hi << 32) | (unsigned)ts_lo) : 0ull;
        if (lane == 62) stamps[62] = rt_entry; if (lane == 63) stamps[63] = (unsigned long long)wall_clock64(); }
#undef PG8_STAMP
#undef PG8_SA
#undef PG8_SB
#undef PG8_STAGE
#undef PG8_LDA
#undef PG8_LDB
#undef PG8_MMA
#undef PG8_WAIT_V
#undef PG8_WAIT_L
#undef PG8_BAR
#undef PG8_SCHED
}
}

using pg8::bf16_t; using pg8::bf16x8; using pg8::f32x4; using pg8::u32x4;
typedef unsigned u32x2 __attribute__((ext_vector_type(2)));
#define LAS __attribute__((address_space(3)))

constexpr int T = 32768, D = 1024, FF = 2816, NGU = 5632, NIN = 2304;
constexpr float ALPHA = 1.4142135623730951f;
constexpr float LN_EPS = 1e-5f;
constexpr int LDS_BYTES = 160 * 1024;
constexpr int NPHASE = 23;
constexpr int LDS_PTAB = 159744;

constexpr size_t SZ_WGU = (size_t)NGU * D * 2, SZ_WD = (size_t)D * FF * 2, SZ_WIN = (size_t)NIN * D * 2, SZ_WOUT = (size_t)D * D * 2;
constexpr size_t SZ_SGUW = 4 * 128 * 128 * 2, SZ_RGW = 2 * 8 * 64 * 64 * 2;
constexpr size_t WS_AGG = 0;
constexpr size_t WS_WGU = 1u << 20;
constexpr size_t WS_WD = WS_WGU + 4 * SZ_WGU;
constexpr size_t WS_WIN = WS_WD + 4 * SZ_WD;
constexpr size_t WS_WOUT = WS_WIN + 2 * SZ_WIN;
constexpr size_t WS_SGUW = WS_WOUT + 2 * SZ_WOUT;
constexpr size_t WS_RGW = WS_SGUW + 2 * SZ_SGUW;
constexpr size_t WS_XB = WS_RGW + 2 * SZ_RGW;
constexpr size_t WS_HZ = WS_XB + (size_t)T * D * 2;
constexpr size_t WS_Y = WS_HZ + (size_t)T * FF * 2;
constexpr size_t WS_END = WS_Y + (size_t)T * D * 2;

struct Params { const float* in[20]; float* out; unsigned char* ws; int ph_lo, ph_hi; };


__device__ __forceinline__ const float* inptr(LAS unsigned char* lds, int i) {
    const u32x2 v = *(LAS const u32x2*)(lds + LDS_PTAB + 8 * i);
    const unsigned long long a = ((unsigned long long)(unsigned)__builtin_amdgcn_readfirstlane((int)v.y) << 32) | (unsigned)__builtin_amdgcn_readfirstlane((int)v.x);
    return (const float*)a;
}

__device__ __forceinline__ float sigmoid_f(float x) { return __builtin_amdgcn_rcpf(1.0f + __builtin_amdgcn_exp2f(-1.4426950408889634f * x)); }
__device__ __forceinline__ float gelu_f(float x) { return x * sigmoid_f(1.5957691216057308f * x * (1.0f + 0.044715f * x * x)); }
__device__ __forceinline__ float bf_lo(unsigned w) { return __uint_as_float(w << 16); }
__device__ __forceinline__ float bf_hi(unsigned w) { return __uint_as_float(w & 0xffff0000u); }
__device__ __forceinline__ unsigned pk_bf16(float lo, float hi) { return pg8::cvt_pk_bf16(lo, hi); }
__device__ __forceinline__ float wave_sum(float v) {
#pragma unroll
    for (int o = 32; o >= 1; o >>= 1) v += __shfl_xor(v, o);
    return v;
}

struct EpiSwiGLU {
    static constexpr bool PERM = true, AFTER_DRAIN = false;
    bf16_t* O;
    __device__ __forceinline__ void operator()(const f32x4 (&acc)[2][2][4][2], const pg8::Unit& u, int wr, int wc, int fr, int fq) const {
        const int row0 = u.pm * 256 + wr * 64 + fr, col0 = u.pn * 128 + wc * 32 + 8 * fq;
#pragma unroll
        for (int ai = 0; ai < 2; ++ai)
#pragma unroll
            for (int m = 0; m < 4; ++m) {
                bf16_t* rowp = O + (size_t)(row0 + ai * 128 + m * 16) * FF + col0;
                const f32x4 g0 = acc[ai][0][m][0], g1 = acc[ai][0][m][1], u0 = acc[ai][1][m][0], u1 = acc[ai][1][m][1];
                float h[8];
#pragma unroll
                for (int j = 0; j < 4; ++j) { h[j] = g0[j] * sigmoid_f(g0[j]) * u0[j]; h[4 + j] = g1[j] * sigmoid_f(g1[j]) * u1[j]; }
                u32x4 w; w.x = pk_bf16(h[0], h[1]); w.y = pk_bf16(h[2], h[3]); w.z = pk_bf16(h[4], h[5]); w.w = pk_bf16(h[6], h[7]);
                *(u32x4*)rowp = w;
            }
    }
};
struct EpiRes {
    static constexpr bool PERM = true, AFTER_DRAIN = false;
    const float* res; float* out; float scale;
    __device__ __forceinline__ void operator()(const f32x4 (&acc)[2][2][4][2], const pg8::Unit& u, int wr, int wc, int fr, int fq) const {
        const int row0 = u.pm * 256 + wr * 64 + fr, col0 = u.pn * 256 + wc * 32 + 8 * fq;
#pragma unroll
        for (int ai = 0; ai < 2; ++ai)
#pragma unroll
            for (int m = 0; m < 4; ++m) {
                const size_t off = (size_t)(row0 + ai * 128 + m * 16) * D + col0;
#pragma unroll
                for (int bj = 0; bj < 2; ++bj)
#pragma unroll
                    for (int n = 0; n < 2; ++n) { const size_t o2 = off + bj * 128 + n * 4; const f32x4 r = *(const f32x4*)(res + o2); *(f32x4*)(out + o2) = ALPHA * r + scale * acc[ai][bj][m][n]; }
                asm volatile("" ::: "memory");
            }
    }
};
struct EpiBf16 {
    static constexpr bool PERM = true, AFTER_DRAIN = false;
    bf16_t* O; int ldc;
    __device__ __forceinline__ void operator()(const f32x4 (&acc)[2][2][4][2], const pg8::Unit& u, int wr, int wc, int fr, int fq) const {
        const int row0 = u.pm * 256 + wr * 64 + fr, col0 = u.pn * 256 + wc * 32 + 8 * fq;
#pragma unroll
        for (int ai = 0; ai < 2; ++ai)
#pragma unroll
            for (int m = 0; m < 4; ++m) {
                bf16_t* rowp = O + (size_t)(row0 + ai * 128 + m * 16) * ldc + col0;
#pragma unroll
                for (int bj = 0; bj < 2; ++bj) { const f32x4 v0 = acc[ai][bj][m][0], v1 = acc[ai][bj][m][1];
                    u32x4 w; w.x = pk_bf16(v0[0], v0[1]); w.y = pk_bf16(v0[2], v0[3]); w.z = pk_bf16(v1[0], v1[1]); w.w = pk_bf16(v1[2], v1[3]);
                    *(u32x4*)(rowp + bj * 128) = w; }
            }
    }
};


struct EpiAny {
    static constexpr bool PERM = true, AFTER_DRAIN = false;
    int mode; bf16_t* O; int ldc; const float* res; float* out; float scale;
    __device__ __forceinline__ void operator()(const f32x4 (&acc)[2][2][4][2], const pg8::Unit& u, int wr, int wc, int fr, int fq) const {
        if (mode == 0) { EpiSwiGLU e{O}; e(acc, u, wr, wc, fr, fq); }
        else if (mode == 1) { EpiRes e{res, out, scale}; e(acc, u, wr, wc, fr, fq); }
        else { EpiBf16 e{O, ldc}; e(acc, u, wr, wc, fr, fq); }
    }
};

__device__ __forceinline__ void prologue_phase(unsigned char* ws, LAS unsigned char* lds, const int tid) {
    LAS float* tile = (LAS float*)lds;
    for (int j = blockIdx.x; j < 10112; j += gridDim.x) {
        const float* src; bf16_t* dst; int K, N, which = -1, t;
        if (j < 5632) { const int m = j / 704; t = j % 704; const int lf = m >> 1; which = m & 1; K = D; N = FF;
            src = inptr(lds, which ? 4 : 3) + (size_t)lf * D * FF; dst = (bf16_t*)(ws + WS_WGU + (size_t)lf * SZ_WGU); }
        else if (j < 8448) { const int j2 = j - 5632, lf = j2 / 704; t = j2 % 704; K = FF; N = D; src = inptr(lds, 5) + (size_t)lf * FF * D; dst = (bf16_t*)(ws + WS_WD + (size_t)lf * SZ_WD); }
        else if (j < 9600) { const int j3 = j - 8448, l = j3 / 576; t = j3 % 576; K = D; N = NIN; src = inptr(lds, 6) + (size_t)l * D * NIN; dst = (bf16_t*)(ws + WS_WIN + (size_t)l * SZ_WIN); }
        else { const int j4 = j - 9600, l = j4 / 256; t = j4 % 256; K = D; N = D; src = inptr(lds, 19) + (size_t)l * D * D; dst = (bf16_t*)(ws + WS_WOUT + (size_t)l * SZ_WOUT); }
        const int ntn = N / 64, k0 = (t / ntn) * 64, n0 = (t % ntn) * 64;
#pragma unroll
        for (int it = 0; it < 8; ++it) { const int i = it * 8 + (tid >> 6), jj = tid & 63; tile[i * 65 + jj] = src[(size_t)(k0 + i) * N + n0 + jj]; }
        __syncthreads();
        const int kp = tid & 31, jq = tid >> 5;
#pragma unroll
        for (int it = 0; it < 4; ++it) { const int jj = it * 16 + jq, n = n0 + jj; const int rho = which < 0 ? n : (256 * (n >> 7) + 128 * which + (n & 127));
            *(unsigned*)(dst + (size_t)rho * K + k0 + 2 * kp) = pk_bf16(tile[(2 * kp) * 65 + jj], tile[(2 * kp + 1) * 65 + jj]); }
        __syncthreads();
    }
    const size_t gtid = (size_t)blockIdx.x * 512 + tid, gsz = (size_t)gridDim.x * 512;
    { const float* x = inptr(lds, 0); bf16_t* xb = (bf16_t*)(ws + WS_XB);
      for (size_t v = gtid; v < (size_t)T * D / 8; v += gsz) { const f32x4 a = *(const f32x4*)(x + v * 8), b = *(const f32x4*)(x + v * 8 + 4);
          u32x4 w; w.x = pk_bf16(a[0], a[1]); w.y = pk_bf16(a[2], a[3]); w.z = pk_bf16(b[0], b[1]); w.w = pk_bf16(b[2], b[3]); *(u32x4*)(xb + v * 8) = w; } }
    for (size_t i = gtid; i < 2 * 4 * 128 * 128; i += gsz) { const int s = (int)(i & 127), tt = (int)((i >> 7) & 127); const float v = s <= tt ? inptr(lds, 9)[i] : 0.f;
        ((bf16_t*)(ws + WS_SGUW))[i] = (bf16_t)(pk_bf16(v, 0.f) & 0xffffu); }
    for (size_t i = gtid; i < 2 * 2 * 8 * 64 * 64; i += gsz) { const int d = (int)(i & 63), e = (int)((i >> 6) & 63), h = (int)((i >> 12) & 7), g = (int)((i >> 15) & 1), l = (int)(i >> 16);
        const float v = inptr(lds, g ? 16 : 14)[(((size_t)l * 8 + h) * 64 + d) * 64 + e];
        ((bf16_t*)(ws + WS_RGW))[i] = (bf16_t)(pk_bf16(v, 0.f) & 0xffffu); }
}

__device__ __forceinline__ void ln_phase(float* X, bf16_t* XB, const float* g, const float* b, const int tid) {
    const int lane = tid & 63, wid = tid >> 6;
    f32x4 gv[4], bv[4];
#pragma unroll
    for (int i = 0; i < 4; ++i) { gv[i] = *(const f32x4*)(g + 4 * lane + 256 * i); bv[i] = *(const f32x4*)(b + 4 * lane + 256 * i); }
    for (int r = blockIdx.x * 8 + wid; r < T; r += gridDim.x * 8) {
        float* xr = X + (size_t)r * D + 4 * lane; f32x4 v[4];
#pragma unroll
        for (int i = 0; i < 4; ++i) v[i] = *(const f32x4*)(xr + 256 * i);
        float s = 0.f;
#pragma unroll
        for (int i = 0; i < 4; ++i) s += (v[i][0] + v[i][1]) + (v[i][2] + v[i][3]);
        const float mean = wave_sum(s) * (1.0f / D);
        float q = 0.f;
#pragma unroll
        for (int i = 0; i < 4; ++i) { v[i] -= mean; q += (v[i][0] * v[i][0] + v[i][1] * v[i][1]) + (v[i][2] * v[i][2] + v[i][3] * v[i][3]); }
        const float rstd = rsqrtf(wave_sum(q) * (1.0f / D) + LN_EPS);
        bf16_t* xbr = XB + (size_t)r * D + 4 * lane;
#pragma unroll
        for (int i = 0; i < 4; ++i) { const f32x4 y = v[i] * rstd * gv[i] + bv[i]; *(f32x4*)(xr + 256 * i) = y;
            u32x2 w; w.x = pk_bf16(y[0], y[1]); w.y = pk_bf16(y[2], y[3]); *(u32x2*)(xbr + 256 * i) = w; }
    }
}

struct MixP { const bf16_t* Z; bf16_t* Y; float* agg; const bf16_t* sguw; const bf16_t* rgw;
    const float *sgu_ln_g, *sgu_ln_b, *sgu_b, *sconv_w, *rg_conv_w, *rg_conv_b, *rg_b_a, *rg_b_i, *rg_lambda; };
constexpr int VT_PITCH = 136;
constexpr int LDS_VT = 0;
constexpr int LDS_RG = 69632;
constexpr int LDS_CONST = 139264;

__device__ __forceinline__ void mix_consts(const MixP& mp, LAS unsigned char* lds, const int tid) {
    LAS float* CW = (LAS float*)(lds + LDS_CONST);
    for (int i = tid; i < 2048; i += 512) CW[i] = mp.rg_conv_w[i];
    CW[2048 + tid] = mp.rg_conv_b[tid]; CW[2560 + tid] = mp.rg_b_a[tid]; CW[3072 + tid] = mp.rg_b_i[tid];
    CW[3584 + tid] = 8.0f * log1pf(expf(-mp.rg_lambda[tid]));
    __syncthreads();
}

template <bool FULL>
__device__ __forceinline__ void rg_tile(const MixP& mp, int tile, LAS unsigned char* lds, int wid, int lane, float carry) {
    const int fr = lane & 15, fq = lane >> 4, h = wid;
    const int t0 = tile * 128, seq0 = (tile >> 7) << 14;
    LAS float* P0 = (LAS float*)(lds + LDS_RG + wid * 8704); LAS float* P1 = P0 + 16 * 68;
    LAS const float* CW = (LAS const float*)(lds + LDS_CONST);
    bf16x8 wf[2][2][4];
#pragma unroll
    for (int g = 0; g < 2; ++g)
#pragma unroll
        for (int ks = 0; ks < 2; ++ks)
#pragma unroll
            for (int n = 0; n < 4; ++n) wf[g][ks][n] = *(const bf16x8*)(mp.rgw + ((size_t)((g * 8 + h) * 64 + 16 * n + fr) * 64 + 32 * ks + 8 * fq));
    float hst = carry, ap = 1.0f;
    const bf16_t* zx = mp.Z + 1792 + 64 * h + 8 * fq;
    const int cbase = 64 * h + 8 * fq;
    for (int g = 0; g < 8; ++g) {
        const int tok = t0 + 16 * g + fr;
        u32x4 xv[4][2];
#pragma unroll
        for (int k = 0; k < 4; ++k) { const int tk = tok - 3 + k; const bool ok = tk >= seq0;
#pragma unroll
            for (int ks = 0; ks < 2; ++ks) xv[k][ks] = ok ? *(const u32x4*)(zx + (size_t)tk * NIN + 32 * ks) : (u32x4){0u, 0u, 0u, 0u}; }
        bf16x8 xa[2];
#pragma unroll
        for (int ks = 0; ks < 2; ++ks) {
            f32x4 c0 = *(LAS const f32x4*)(CW + 2048 + cbase + 32 * ks), c1 = *(LAS const f32x4*)(CW + 2048 + cbase + 32 * ks + 4);
#pragma unroll
            for (int k = 0; k < 4; ++k) { const f32x4 w0 = *(LAS const f32x4*)(CW + k * 512 + cbase + 32 * ks), w1 = *(LAS const f32x4*)(CW + k * 512 + cbase + 32 * ks + 4); const u32x4 x = xv[k][ks];
                c0[0] += w0[0] * bf_lo(x.x); c0[1] += w0[1] * bf_hi(x.x); c0[2] += w0[2] * bf_lo(x.y); c0[3] += w0[3] * bf_hi(x.y);
                c1[0] += w1[0] * bf_lo(x.z); c1[1] += w1[1] * bf_hi(x.z); c1[2] += w1[2] * bf_lo(x.w); c1[3] += w1[3] * bf_hi(x.w); }
            *(LAS f32x4*)(P0 + fr * 68 + 32 * ks + 8 * fq) = c0; *(LAS f32x4*)(P0 + fr * 68 + 32 * ks + 8 * fq + 4) = c1;
            u32x4 pk; pk.x = pk_bf16(c0[0], c0[1]); pk.y = pk_bf16(c0[2], c0[3]); pk.z = pk_bf16(c1[0], c1[1]); pk.w = pk_bf16(c1[2], c1[3]);
            xa[ks] = __builtin_bit_cast(bf16x8, pk);
        }
        f32x4 ar[4], ai[4];
#pragma unroll
        for (int n = 0; n < 4; ++n) { ar[n] = (f32x4){0.f, 0.f, 0.f, 0.f}; ai[n] = (f32x4){0.f, 0.f, 0.f, 0.f};
#pragma unroll
            for (int ks = 0; ks < 2; ++ks) { ar[n] = __builtin_amdgcn_mfma_f32_16x16x32_bf16(wf[0][ks][n], xa[ks], ar[n], 0, 0, 0); ai[n] = __builtin_amdgcn_mfma_f32_16x16x32_bf16(wf[1][ks][n], xa[ks], ai[n], 0, 0, 0); } }
        asm volatile("s_waitcnt lgkmcnt(0)" ::: "memory");
        f32x4 av[4], bv[4];
#pragma unroll
        for (int n = 0; n < 4; ++n) { const int e = 64 * h + 16 * n + 4 * fq;
            const f32x4 ba = *(LAS const f32x4*)(CW + 2560 + e), bi = *(LAS const f32x4*)(CW + 3072 + e), sp = *(LAS const f32x4*)(CW + 3584 + e), xc = *(LAS const f32x4*)(P0 + fr * 68 + 16 * n + 4 * fq);
#pragma unroll
            for (int j = 0; j < 4; ++j) { const float r = sigmoid_f(ar[n][j] + ba[j]), ig = sigmoid_f(ai[n][j] + bi[j]);
                const float a = __builtin_amdgcn_exp2f(-1.4426950408889634f * r * sp[j]); const float m2 = fmaxf(1.0f - a * a, 0.0f);
                av[n][j] = a; bv[n][j] = __builtin_amdgcn_sqrtf(m2) * (ig * xc[j]); } }
        asm volatile("s_waitcnt lgkmcnt(0)" ::: "memory");
#pragma unroll
        for (int n = 0; n < 4; ++n) { *(LAS f32x4*)(P0 + fr * 68 + 16 * n + 4 * fq) = av[n]; *(LAS f32x4*)(P1 + fr * 68 + 16 * n + 4 * fq) = bv[n]; }
        asm volatile("s_waitcnt lgkmcnt(0)" ::: "memory");
#pragma unroll
        for (int t = 0; t < 16; ++t) { const float a = P0[t * 68 + lane], b = P1[t * 68 + lane]; hst = a * hst + b; if (!FULL) ap *= a; if (FULL) P1[t * 68 + lane] = hst; }
        if (FULL) {
            asm volatile("s_waitcnt lgkmcnt(0)" ::: "memory");
#pragma unroll
            for (int it = 0; it < 2; ++it) { const int tkn = it * 8 + (lane >> 3), c8 = (lane & 7) * 8; const size_t tg = (size_t)(t0 + 16 * g + tkn);
                const f32x4 h0 = *(LAS const f32x4*)(P1 + tkn * 68 + c8), h1 = *(LAS const f32x4*)(P1 + tkn * 68 + c8 + 4);
                const u32x4 gt = *(const u32x4*)(mp.Z + tg * NIN + 1280 + 64 * h + c8);
                u32x4 w; w.x = pk_bf16(gelu_f(bf_lo(gt.x)) * h0[0], gelu_f(bf_hi(gt.x)) * h0[1]); w.y = pk_bf16(gelu_f(bf_lo(gt.y)) * h0[2], gelu_f(bf_hi(gt.y)) * h0[3]);
                w.z = pk_bf16(gelu_f(bf_lo(gt.z)) * h1[0], gelu_f(bf_hi(gt.z)) * h1[1]); w.w = pk_bf16(gelu_f(bf_lo(gt.w)) * h1[2], gelu_f(bf_hi(gt.w)) * h1[3]);
                *(u32x4*)(mp.Y + tg * D + 512 + 64 * h + c8) = w; }
            asm volatile("s_waitcnt lgkmcnt(0)" ::: "memory");
        }
    }
    if (!FULL) { mp.agg[(size_t)tile * 1024 + 64 * h + lane] = ap; mp.agg[(size_t)tile * 1024 + 512 + 64 * h + lane] = hst; }
}

__device__ __forceinline__ void mix1_phase(const MixP& mp, LAS unsigned char* lds, const int tid) {
    const int lane = tid & 63, wid = __builtin_amdgcn_readfirstlane(tid >> 6);
    mix_consts(mp, lds, tid);
    for (int tile = blockIdx.x; tile < 256; tile += gridDim.x) rg_tile<false>(mp, tile, lds, wid, lane, 0.0f);
}

__device__ __forceinline__ void mix2_phase(const MixP& mp, LAS unsigned char* lds, const int tid) {
    const int lane = tid & 63, wid = __builtin_amdgcn_readfirstlane(tid >> 6), fr = lane & 15, fq = lane >> 4;
    mix_consts(mp, lds, tid);
    LAS bf16_t* VT = (LAS bf16_t*)(lds + LDS_VT);
    for (int tile = blockIdx.x; tile < 256; tile += gridDim.x) {
        const int t0 = tile * 128, seq0 = (tile >> 7) << 14;
        {
            const f32x4 gch = *(const f32x4*)(mp.sgu_ln_g + 4 * lane), bch = *(const f32x4*)(mp.sgu_ln_b + 4 * lane);
            u32x2 raw[16];
#pragma unroll
            for (int i = 0; i < 16; ++i) raw[i] = *(const u32x2*)(mp.Z + (size_t)(t0 + 16 * wid + i) * NIN + 256 + 4 * lane);
            unsigned wv[4][8];
#pragma unroll
            for (int i2 = 0; i2 < 8; ++i2) {
                f32x4 vn[2];
#pragma unroll
                for (int e = 0; e < 2; ++e) { const u32x2 rw = raw[2 * i2 + e];
                    f32x4 v = {gelu_f(bf_lo(rw.x)), gelu_f(bf_hi(rw.x)), gelu_f(bf_lo(rw.y)), gelu_f(bf_hi(rw.y))};
                    const float mean = wave_sum((v[0] + v[1]) + (v[2] + v[3])) * (1.0f / 256.0f);
                    v -= mean;
                    const float rstd = rsqrtf(wave_sum((v[0] * v[0] + v[1] * v[1]) + (v[2] * v[2] + v[3] * v[3])) * (1.0f / 256.0f) + LN_EPS);
                    vn[e] = v * rstd * gch + bch; }
#pragma unroll
                for (int q = 0; q < 4; ++q) wv[q][i2] = pk_bf16(vn[0][q], vn[1][q]);
            }
#pragma unroll
            for (int q = 0; q < 4; ++q)
#pragma unroll
                for (int hf = 0; hf < 2; ++hf) { u32x4 w; w.x = wv[q][4 * hf]; w.y = wv[q][4 * hf + 1]; w.z = wv[q][4 * hf + 2]; w.w = wv[q][4 * hf + 3];
                    *(LAS u32x4*)(VT + (4 * lane + q) * VT_PITCH + 16 * wid + 8 * hf) = w; }
        }
        __syncthreads();
        {
            const int hd = wid >> 1, th = wid & 1;
            bf16x8 vf[4][4];
#pragma unroll
            for (int n = 0; n < 4; ++n)
#pragma unroll
                for (int ks = 0; ks < 4; ++ks) vf[n][ks] = *(LAS const bf16x8*)(VT + (64 * hd + 16 * n + fr) * VT_PITCH + 32 * ks + 8 * fq);
#pragma unroll
            for (int m = 0; m < 4; ++m) {
                const int trow = 64 * th + 16 * m + fr;
                bf16x8 wfr[4];
#pragma unroll
                for (int ks = 0; ks < 4; ++ks) wfr[ks] = *(const bf16x8*)(mp.sguw + ((size_t)(hd * 128 + trow) * 128 + 32 * ks + 8 * fq));
                f32x4 acc[4];
#pragma unroll
                for (int n = 0; n < 4; ++n) { acc[n] = (f32x4){0.f, 0.f, 0.f, 0.f};
#pragma unroll
                    for (int ks = 0; ks < 4; ++ks) acc[n] = __builtin_amdgcn_mfma_f32_16x16x32_bf16(vf[n][ks], wfr[ks], acc[n], 0, 0, 0); }
                const float bs = mp.sgu_b[hd * 128 + trow];
                const size_t tg = (size_t)(t0 + trow);
#pragma unroll
                for (int n = 0; n < 4; ++n) { const int c = 64 * hd + 16 * n + 4 * fq; const u32x2 uu = *(const u32x2*)(mp.Z + tg * NIN + c);
                    u32x2 w; w.x = pk_bf16(gelu_f(bf_lo(uu.x)) * (acc[n][0] + bs), gelu_f(bf_hi(uu.x)) * (acc[n][1] + bs));
                    w.y = pk_bf16(gelu_f(bf_lo(uu.y)) * (acc[n][2] + bs), gelu_f(bf_hi(uu.y)) * (acc[n][3] + bs));
                    *(u32x2*)(mp.Y + tg * D + c) = w; }
            }
        }
#pragma unroll 2
        for (int it = 0; it < 8; ++it) {
            const int item = tid + 512 * it, tkl = item >> 5, c8 = (item & 31) * 8, tok = t0 + tkl;
            const u32x4 bg = *(const u32x4*)(mp.Z + (size_t)tok * NIN + 512 + c8);
            float acc[8];
#pragma unroll
            for (int i = 0; i < 8; ++i) acc[i] = 0.f;
#pragma unroll
            for (int k = 0; k < 3; ++k) { const int tk = tok - 2 + k;
                if (tk >= seq0) { const u32x4 cgv = *(const u32x4*)(mp.Z + (size_t)tk * NIN + 768 + c8), xi = *(const u32x4*)(mp.Z + (size_t)tk * NIN + 1024 + c8);
                    const f32x4 w0 = *(const f32x4*)(mp.sconv_w + k * 256 + c8), w1 = *(const f32x4*)(mp.sconv_w + k * 256 + c8 + 4);
                    acc[0] += w0[0] * (bf_lo(cgv.x) * bf_lo(xi.x)); acc[1] += w0[1] * (bf_hi(cgv.x) * bf_hi(xi.x)); acc[2] += w0[2] * (bf_lo(cgv.y) * bf_lo(xi.y)); acc[3] += w0[3] * (bf_hi(cgv.y) * bf_hi(xi.y));
                    acc[4] += w1[0] * (bf_lo(cgv.z) * bf_lo(xi.z)); acc[5] += w1[1] * (bf_hi(cgv.z) * bf_hi(xi.z)); acc[6] += w1[2] * (bf_lo(cgv.w) * bf_lo(xi.w)); acc[7] += w1[3] * (bf_hi(cgv.w) * bf_hi(xi.w)); } }
            u32x4 w; w.x = pk_bf16(bf_lo(bg.x) * acc[0], bf_hi(bg.x) * acc[1]); w.y = pk_bf16(bf_lo(bg.y) * acc[2], bf_hi(bg.y) * acc[3]);
            w.z = pk_bf16(bf_lo(bg.z) * acc[4], bf_hi(bg.z) * acc[5]); w.w = pk_bf16(bf_lo(bg.w) * acc[6], bf_hi(bg.w) * acc[7]);
            *(u32x4*)(mp.Y + (size_t)tok * D + 256 + c8) = w;
        }
        {
            const int pt = tile & 127, tb = tile - pt, ch = 64 * wid + lane; float c = 0.f;
            for (int q = 0; q < pt; ++q) { const float a = mp.agg[(size_t)(tb + q) * 1024 + ch], hb = mp.agg[(size_t)(tb + q) * 1024 + 512 + ch]; c = a * c + hb; }
            rg_tile<true>(mp, tile, lds, wid, lane, c);
        }
        __syncthreads();
    }
}

__global__ void __launch_bounds__(512, 2) mega(Params p) {
    extern __shared__ __attribute__((aligned(16))) unsigned char lds_raw[];
    LAS unsigned char* lds = (LAS unsigned char*)lds_raw;
    cg::grid_group grid = cg::this_grid();
    if (threadIdx.x == 0) {
        LAS unsigned long long* pt = (LAS unsigned long long*)(lds + LDS_PTAB);
#define PT(i) pt[i] = (unsigned long long)p.in[i];
        PT(0) PT(1) PT(2) PT(3) PT(4) PT(5) PT(6) PT(7) PT(8) PT(9) PT(10) PT(11) PT(12) PT(13) PT(14) PT(15) PT(16) PT(17) PT(18) PT(19)
#undef PT
    }
    __syncthreads();
    for (int ph = p.ph_lo; ph < p.ph_hi; ++ph) {
        unsigned char* ws = p.ws; float* outp = p.out; int tid = threadIdx.x;
        asm volatile("" : "+s"(ws), "+s"(outp), "+v"(tid));
        bf16_t* XB = (bf16_t*)(ws + WS_XB); bf16_t* HZ = (bf16_t*)(ws + WS_HZ); bf16_t* Y = (bf16_t*)(ws + WS_Y);
#ifndef NO_PRO
        if (ph == 0) prologue_phase(ws, lds, tid);
        else
#endif
        {
            const int l = (ph - 1) / 11, q = (ph - 1) % 11;
            if (q == 2 || q == 7 || q == 10) {
                const int k = q == 2 ? 0 : (q == 7 ? 1 : 2);
#ifndef NO_LN
                ln_phase(outp, XB, inptr(lds, 1) + (size_t)(l * 3 + k) * D, inptr(lds, 2) + (size_t)(l * 3 + k) * D, tid);
#endif
            } else if (q != 4 && q != 5) {
                pg8::Gemm g; EpiAny E{};
                if (q == 0 || q == 8) {
                    const int lf = l * 2 + (q == 8);
                    g = pg8::Gemm{XB, (const bf16_t*)(ws + WS_WGU + (size_t)lf * SZ_WGU), T, NGU, D}; E.mode = 0; E.O = HZ; E.ldc = FF;
                } else if (q == 3) {
                    g = pg8::Gemm{XB, (const bf16_t*)(ws + WS_WIN + (size_t)l * SZ_WIN), T, NIN, D}; E.mode = 2; E.O = HZ; E.ldc = NIN;
                } else {
                    E.mode = 1; E.res = (l == 0 && q == 1) ? inptr(lds, 0) : outp; E.out = outp;
                    if (q == 6) { g = pg8::Gemm{Y, (const bf16_t*)(ws + WS_WOUT + (size_t)l * SZ_WOUT), T, D, D}; E.scale = 1.0f; }
                    else { const int lf = l * 2 + (q == 9); g = pg8::Gemm{HZ, (const bf16_t*)(ws + WS_WD + (size_t)lf * SZ_WD), T, D, FF}; E.scale = 0.5f; }
                }
                pg8::StaticOrder S; S.init(g.M, g.N, gridDim.x, blockIdx.x);
#ifndef NO_G1
                pg8::gemm_phase<EpiAny, pg8::StaticOrder>(lds, g, S, E, nullptr);
#endif
            } else {
                MixP mp{HZ, Y, (float*)(ws + WS_AGG), (const bf16_t*)(ws + WS_SGUW + (size_t)l * SZ_SGUW), (const bf16_t*)(ws + WS_RGW + (size_t)l * SZ_RGW),
                        inptr(lds, 7) + l * 256, inptr(lds, 8) + l * 256, inptr(lds, 10) + l * 512, inptr(lds, 11) + l * 768, inptr(lds, 12) + l * 2048, inptr(lds, 13) + l * 512, inptr(lds, 15) + l * 512, inptr(lds, 17) + l * 512, inptr(lds, 18) + l * 512};
#ifndef NO_MIX1
                if (q == 4) mix1_phase(mp, lds, tid);
#endif
#ifndef NO_MIX2
                if (q == 5) mix2_phase(mp, lds, tid);
#endif
            }
        }
        if (ph + 1 < p.ph_hi) grid.sync();
    }
}

extern "C" void kernel_launch(void* const* d_in, const int* in_sizes, int n_in, void* d_out, int out_size, void* d_ws, size_t ws_size, hipStream_t stream) {
    static int grid = 0;
    if (grid == 0) {
        if (n_in != 20 || out_size != T * D || ws_size < WS_END) { fprintf(stderr, "kernel_launch: unexpected shapes (n_in %d out %d ws %zu need %zu)\n", n_in, out_size, ws_size, (size_t)WS_END); grid = -1; return; }
        int dev = 0, cus = 0, per_cu = 0;
        hipGetDevice(&dev); hipDeviceGetAttribute(&cus, hipDeviceAttributeMultiprocessorCount, dev);
        if (hipFuncSetAttribute((const void*)mega, hipFuncAttributeMaxDynamicSharedMemorySize, LDS_BYTES) != hipSuccess) { fprintf(stderr, "kernel_launch: hipFuncSetAttribute failed\n"); grid = -1; return; }
        if (hipOccupancyMaxActiveBlocksPerMultiprocessor(&per_cu, (const void*)mega, 512, LDS_BYTES) != hipSuccess || per_cu < 1) { fprintf(stderr, "kernel_launch: occupancy query says %d\n", per_cu); per_cu = 1; }
        (void)hipGetLastError();
        grid = cus * per_cu;
    }
    if (grid < 0) return;
    Params p{};
    for (int i = 0; i < 20; ++i) p.in[i] = (const float*)d_in[i];
    p.out = (float*)d_out; p.ws = (unsigned char*)d_ws; p.ph_lo = 0; p.ph_hi = NPHASE;
    void* args[] = {&p};
    hipError_t e = hipLaunchCooperativeKernel((const void*)mega, dim3(grid), dim3(512), args, LDS_BYTES, stream);
    if (e != hipSuccess) fprintf(stderr, "kernel_launch: cooperative launch failed: %s (grid %d)\n", hipGetErrorString(e), grid);
}
```

```cpp
#include <hip/hip_runtime.h>
#include <hip/hip_cooperative_groups.h>
#include <cstdio>
namespace cg = cooperative_groups;
namespace pg8 {
#define PG8_LAS __attribute__((address_space(3)))
typedef unsigned short bf16_t;
typedef short bf16x8 __attribute__((ext_vector_type(8)));
typedef float f32x4 __attribute__((ext_vector_type(4)));
typedef unsigned u32x4 __attribute__((ext_vector_type(4)));
constexpr int BM = 256, BK = 64, HALF = 128, HTB = HALF * BK * 2  , STAGE_BYTES = 8 * HTB, NXCD = 8, WGM = 8;

__host__ __device__ __forceinline__ int lds_byte(int r, int c) { const int st = (r >> 4) * 2 + (c >> 5), rr = r & 15, cc = c & 31, ob = rr * 64 + cc * 2; return st * 1024 + (ob ^ (((ob >> 9) & 1) << 5)); }
__host__ __device__ __forceinline__ void stage_rc(int b, int& R, int& C) { const int st = b / 1024, sb = b % 1024, swz = sb ^ (((sb >> 9) & 1) << 5); R = (st >> 1) * 16 + swz / 64; C = (st & 1) * 32 + (swz % 64) / 2; }
__host__ __device__ __forceinline__ int perm32(int rho) { const int n = rho >> 4, i = rho & 15; return 8 * (i >> 2) + 4 * n + (i & 3); }

struct Unit { int pm, pn; };
struct Gemm { const bf16_t* A; const bf16_t* Bt; int M, N, K; };

struct StaticOrder {
    int nM, nN, nwg, G, c;
    __host__ __device__ void init(int M, int N, int G_, int c_) { nM = M / BM; nN = N / BM; nwg = nM * nN; G = G_; c = c_; }
    __host__ __device__ bool next(int i, Unit& u) const {
        const long L = (long)i * G + c; if (L >= nwg) return false;
        int wgid = (int)L; { const int q = nwg / NXCD, r = nwg % NXCD, xcd = wgid % NXCD, off = wgid / NXCD; wgid = (xcd < r ? xcd * (q + 1) : r * (q + 1) + (xcd - r) * q) + off; }
        const int nig = WGM * nN, gid = wgid / nig, fm = gid * WGM, gsz = (nM - fm) < WGM ? (nM - fm) : WGM;
        u.pm = fm + ((wgid % nig) % gsz); u.pn = (wgid % nig) / gsz; return true;
    }
    __device__ __forceinline__ void a_ready(const Unit&) const {}
    __device__ __forceinline__ void done(const Unit&) const {}
};
__device__ __forceinline__ unsigned cvt_pk_bf16(float lo, float hi) { unsigned r; asm volatile("v_cvt_pk_bf16_f32 %0, %1, %2" : "=v"(r) : "v"(lo), "v"(hi)); return r; }
template <class Epi, class Sched, bool STAMP = false>
__device__ __forceinline__ void gemm_phase(PG8_LAS unsigned char* lds, const Gemm g, const Sched& S, const Epi& E, unsigned long long* stamps, const int tid) {
    const int wid = __builtin_amdgcn_readfirstlane(tid >> 6), lane = tid & 63, wr = wid >> 2, wc = wid & 3, fr = lane & 15, fq = lane >> 4;
    const int K = g.K, nt = K / BK;
    int ts_lo = 0, ts_hi = 0, nts = 0; const unsigned long long rt_entry = STAMP ? (unsigned long long)wall_clock64() : 0ull;
#define PG8_STAMP() do { if (STAMP && wid == 0 && nts < 64) { const unsigned long long _c = (unsigned long long)clock64(); \
        ts_lo = (lane == nts) ? (int)(unsigned)_c : ts_lo; ts_hi = (lane == nts) ? (int)(unsigned)(_c >> 32) : ts_hi; ++nts; } } while (0)
    PG8_STAMP();
    unsigned voffA[2], voffB[2];
#pragma unroll
    for (int i = 0; i < 2; ++i) { int R, C; stage_rc(tid * 16 + i * 8192, R, C); const int Rb = Epi::PERM ? ((R & ~31) + perm32(R & 31)) : R;
        voffA[i] = (unsigned)(R * K + C) * 2u; voffB[i] = (unsigned)(Rb * K + C) * 2u; }
    const size_t kstep = (size_t)(BK * 2);
    const size_t hstep = (size_t)HALF * K * 2;
    const size_t tstep = 2 * hstep;
    const unsigned ldsw = (unsigned)wid * 1024u;
    const int aoff = lds_byte(wr * 64 + fr, fq * 8), boff = lds_byte(wc * 32 + fr, fq * 8);
#define PG8_SA(b, h) (((b) * 2 + (h)) * HTB)
#define PG8_SB(b, h) ((4 + (b) * 2 + (h)) * HTB)
#define PG8_STAGE(bufoff, gbase, voff) do { _Pragma("unroll") for (int _i = 0; _i < 2; ++_i) \
        __builtin_amdgcn_global_load_lds((const unsigned*)((const char*)(gbase) + (voff)[_i]), (PG8_LAS unsigned*)(lds + (bufoff) + ldsw + _i * 8192), 16, 0, 0); } while (0)
#define PG8_LDA(dst, b, h) do { _Pragma("unroll") for (int m = 0; m < 4; ++m) _Pragma("unroll") for (int k = 0; k < 2; ++k) dst[m][k] = *(const PG8_LAS bf16x8*)(lds + PG8_SA(b, h) + aoff + m * 2048 + k * 1024); } while (0)
#define PG8_LDB(dst, b, h) do { _Pragma("unroll") for (int n = 0; n < 2; ++n) _Pragma("unroll") for (int k = 0; k < 2; ++k) dst[n][k] = *(const PG8_LAS bf16x8*)(lds + PG8_SB(b, h) + boff + n * 2048 + k * 1024); } while (0)
#define PG8_MMA(ai, bj, At, Bt) do { __builtin_amdgcn_s_setprio(1); _Pragma("unroll") for (int m = 0; m < 4; ++m) _Pragma("unroll") for (int n = 0; n < 2; ++n) _Pragma("unroll") for (int k = 0; k < 2; ++k) \
        acc[ai][bj][m][n] = __builtin_amdgcn_mfma_f32_16x16x32_bf16(Bt[n][k], At[m][k], acc[ai][bj][m][n], 0, 0, 0); __builtin_amdgcn_s_setprio(0); } while (0)
#define PG8_WAIT_V(n) asm volatile("s_waitcnt vmcnt(" #n ")" ::: "memory")
#define PG8_WAIT_L(n) asm volatile("s_waitcnt lgkmcnt(" #n ")" ::: "memory")
#define PG8_BAR __builtin_amdgcn_s_barrier()
#define PG8_SCHED __builtin_amdgcn_sched_barrier(0)
    Unit cur, nxt; int ui = 0;
    if (!S.next(0, cur)) return;
    f32x4 acc[2][2][4][2];
#pragma unroll
    for (int a = 0; a < 2; ++a)
#pragma unroll
        for (int b = 0; b < 2; ++b)
#pragma unroll
            for (int m = 0; m < 4; ++m)
#pragma unroll
                for (int n = 0; n < 2; ++n) acc[a][b][m][n] = (f32x4){0.f, 0.f, 0.f, 0.f};
    bf16x8 At[4][2], B0[2][2], B1[2][2];
    const char* cA = (const char*)g.A + (size_t)cur.pm * tstep; const char* cB = (const char*)g.Bt + (size_t)cur.pn * tstep;
    S.a_ready(cur);
    PG8_STAGE(PG8_SB(0, 0), cB, voffB); PG8_STAGE(PG8_SA(0, 0), cA, voffA); PG8_STAGE(PG8_SB(0, 1), cB + hstep, voffB); PG8_STAGE(PG8_SA(0, 1), cA + hstep, voffA);
    if (wr == 1) PG8_BAR;
    PG8_WAIT_V(4); PG8_BAR;
    PG8_STAGE(PG8_SB(1, 0), cB + kstep, voffB); PG8_STAGE(PG8_SA(1, 0), cA + kstep, voffA); PG8_STAGE(PG8_SB(1, 1), cB + hstep + kstep, voffB);
    PG8_WAIT_V(6); PG8_BAR;
    PG8_STAMP();
    for (;;) {
        const bool has_next = S.next(ui + 1, nxt);
        const char* nA = has_next ? (const char*)g.A + (size_t)nxt.pm * tstep : cA; const char* nB = has_next ? (const char*)g.Bt + (size_t)nxt.pn * tstep : cB;
        for (int t = 0; t < nt; t += 2) {
            const bool last = (t == nt - 2);
            const char* a1 = cA + (size_t)(t + 1) * kstep;
            const char* a2 = last ? nA : cA + (size_t)(t + 2) * kstep; const char* b2 = last ? nB : cB + (size_t)(t + 2) * kstep;
            const char* a3 = a2 + kstep; const char* b3 = b2 + kstep;
            if (last && has_next) S.a_ready(nxt);
            PG8_LDB(B0, 0, 0); PG8_SCHED; PG8_LDA(At, 0, 0); PG8_STAGE(PG8_SA(1, 1), a1 + hstep, voffA);
            PG8_WAIT_L(8); PG8_BAR; PG8_WAIT_L(0); PG8_MMA(0, 0, At, B0); PG8_BAR; PG8_SCHED;
            PG8_LDB(B1, 0, 1); PG8_STAGE(PG8_SB(0, 0), b2, voffB);
            PG8_BAR; PG8_WAIT_L(0); PG8_MMA(0, 1, At, B1); PG8_BAR;
            PG8_LDA(At, 0, 1); PG8_STAGE(PG8_SA(0, 0), a2, voffA);
            PG8_BAR; PG8_WAIT_L(0); PG8_MMA(1, 0, At, B0); PG8_BAR; PG8_SCHED;
            PG8_STAGE(PG8_SB(0, 1), b2 + hstep, voffB);
            PG8_WAIT_V(6); PG8_BAR; PG8_MMA(1, 1, At, B1); PG8_BAR;
            PG8_LDB(B0, 1, 0); PG8_SCHED; PG8_LDA(At, 1, 0); PG8_STAGE(PG8_SA(0, 1), a2 + hstep, voffA);
            PG8_WAIT_L(8); PG8_BAR; PG8_WAIT_L(0); PG8_MMA(0, 0, At, B0); PG8_BAR; PG8_SCHED;
            PG8_LDB(B1, 1, 1); PG8_STAGE(PG8_SB(1, 0), b3, voffB);
            PG8_BAR; PG8_WAIT_L(0); PG8_MMA(0, 1, At, B1); PG8_BAR;
            PG8_LDA(At, 1, 1); PG8_STAGE(PG8_SA(1, 0), a3, voffA);
            PG8_BAR; PG8_WAIT_L(0); PG8_MMA(1, 0, At, B0); PG8_BAR; PG8_SCHED;
            PG8_STAGE(PG8_SB(1, 1), b3 + hstep, voffB);
            PG8_WAIT_V(6); PG8_BAR; PG8_MMA(1, 1, At, B1); PG8_BAR;
        }
        PG8_STAMP();
        if constexpr (!Epi::AFTER_DRAIN) { E(acc, cur, wr, wc, fr, fq); S.done(cur); }
        PG8_STAMP();
        if (!has_next) break;
#pragma unroll
        for (int a = 0; a < 2; ++a)
#pragma unroll
            for (int b = 0; b < 2; ++b)
#pragma unroll
                for (int m = 0; m < 4; ++m)
#pragma unroll
                    for (int n = 0; n < 2; ++n) acc[a][b][m][n] = (f32x4){0.f, 0.f, 0.f, 0.f};
        cur = nxt; cA = nA; cB = nB; ++ui;
    }
    PG8_WAIT_V(0);
    if (wr == 0) PG8_BAR;
    PG8_BAR;
    if constexpr (Epi::AFTER_DRAIN) { E.fused(acc, cur, wr, wc, fr, fq, lds, wid, lane); S.done(cur); }
    PG8_STAMP();
    if (STAMP && wid == 0) { stamps[lane] = lane < nts ? (((unsigned long long)(unsigned)ts_hi << 32) | (unsigned)ts_lo) : 0ull;
        if (lane == 62) stamps[62] = rt_entry; if (lane == 63) stamps[63] = (unsigned long long)wall_clock64(); }
#undef PG8_STAMP
#undef PG8_SA
#undef PG8_SB
#undef PG8_STAGE
#undef PG8_LDA
#undef PG8_LDB
#undef PG8_MMA
#undef PG8_WAIT_V
#undef PG8_WAIT_L
#undef PG8_BAR
#undef PG8_SCHED
}
}

using pg8::bf16_t; using pg8::bf16x8; using pg8::f32x4; using pg8::u32x4;
typedef unsigned u32x2 __attribute__((ext_vector_type(2)));
#define LAS __attribute__((address_space(3)))

#define XB_TMO      128
#define XB_XCNT(j)  (256  + 64 * (j))
#define XB_XSUB(j)  (1280 + 64 * (j))
#define XB_XGEN(j)  (2304 + 64 * (j))
#define XB_TOP      3328
#define XB_TOPGEN   3392
#define XCD_BAR_WORDS 3456
#define XB_SPIN_CAP (1u << 18)

__device__ __forceinline__ unsigned xb_ld(unsigned* p)              { return __hip_atomic_load(p, __ATOMIC_RELAXED, __HIP_MEMORY_SCOPE_AGENT); }
__device__ __forceinline__ unsigned xb_add(unsigned* p, unsigned v) { return __hip_atomic_fetch_add(p, v, __ATOMIC_RELAXED, __HIP_MEMORY_SCOPE_AGENT); }
__device__ __forceinline__ unsigned xb_xcc_id() { return (unsigned)__builtin_amdgcn_s_getreg((3 << 11) | 20) & 0xFu; }
#define XB_SPIN(cond, bar) do { unsigned _sp = 0; while (cond) { __builtin_amdgcn_s_sleep(1); \
    if ((++_sp & 255u) == 0u) { if (xb_ld(&(bar)[XB_TMO])) break; if (_sp > XB_SPIN_CAP) { atomicAdd(&(bar)[XB_TMO], 1u); break; } } } } while (0)

struct XcdBarrier {
    unsigned* bar; unsigned x;
    volatile LAS unsigned* st;
};

__device__ __forceinline__ XcdBarrier xcd_barrier_post(unsigned* bar, volatile LAS unsigned* st) {
    XcdBarrier b; b.bar = bar; b.x = xb_xcc_id(); b.st = st;
    if (threadIdx.x == 0) (void)xb_add(&bar[XB_XCNT(b.x)], 1u);
    return b;
}
__device__ __forceinline__ void xcd_barrier_complete(unsigned* bar, unsigned x, unsigned& nloc, unsigned& nx) {
    const unsigned G = gridDim.x * gridDim.y * gridDim.z;
    unsigned sum, cnt, mine, sp = 0u;
    for (;;) {
        sum = 0u; cnt = 0u; mine = 0u;
#pragma unroll
        for (unsigned j = 0; j < 16; ++j) { const unsigned c = xb_ld(&bar[XB_XCNT(j)]); sum += c; cnt += (c > 0u) ? 1u : 0u; mine = (j == x) ? c : mine; }
        if (sum == G) break;
        __builtin_amdgcn_s_sleep(1);
        if ((++sp & 255u) == 0u) { if (xb_ld(&bar[XB_TMO])) break; if (sp > XB_SPIN_CAP) { atomicAdd(&bar[XB_TMO], 1u); break; } }
    }
    nloc = mine > 0u ? mine : 1u; nx = cnt > 0u ? cnt : 1u;
}

__device__ __forceinline__ void xcd_barrier(const XcdBarrier& b) {
    asm volatile("s_waitcnt vmcnt(0)" ::: "memory");
    __syncthreads();
    if (threadIdx.x == 0) {
        unsigned* bar = b.bar;
        __builtin_amdgcn_s_waitcnt(0);
        unsigned nloc = b.st[0], nx = b.st[1];
        if (nloc == 0u) { xcd_barrier_complete(bar, b.x, nloc, nx); b.st[0] = nloc; b.st[1] = nx; }
        const unsigned old = xb_add(&bar[XB_XSUB(b.x)], 1u);
        const unsigned gen = old / nloc;
        if (old + 1u == (gen + 1u) * nloc) {
            __builtin_amdgcn_fence(__ATOMIC_RELEASE, "agent");
            asm volatile("s_waitcnt vmcnt(0)" ::: "memory");
            const unsigned og = xb_add(&bar[XB_TOP], 1u);
            const unsigned tg = og / nx;
            if (og + 1u == (tg + 1u) * nx) xb_add(&bar[XB_TOPGEN], 1u);
            else XB_SPIN(xb_ld(&bar[XB_TOPGEN]) == tg, bar);
            __builtin_amdgcn_fence(__ATOMIC_ACQUIRE, "agent");
            xb_add(&bar[XB_XGEN(b.x)], 1u);
            asm volatile("s_waitcnt vmcnt(0)" ::: "memory");
        } else {
            XB_SPIN(xb_ld(&bar[XB_XGEN(b.x)]) == gen, bar);
            __builtin_amdgcn_fence(__ATOMIC_ACQUIRE, "agent");
            asm volatile("s_waitcnt vmcnt(0)" ::: "memory");
        }
    }
    __syncthreads();
}


constexpr int T = 32768, D = 1024, FF = 2816, NGU = 5632, NIN = 2304;
constexpr float ALPHA = 1.4142135623730951f;
constexpr float LN_EPS = 1e-5f;
constexpr int LDS_BYTES = 160 * 1024;
constexpr int NPHASE = 23;
constexpr int LDS_PTAB = 159744;

constexpr size_t SZ_WGU = (size_t)NGU * D * 2, SZ_WD = (size_t)D * FF * 2, SZ_WIN = (size_t)NIN * D * 2, SZ_WOUT = (size_t)D * D * 2;
constexpr size_t SZ_SGUW = 4 * 128 * 128 * 2, SZ_RGW = 2 * 8 * 64 * 64 * 2;
constexpr size_t WS_AGG = 0;
constexpr size_t WS_WGU = 1u << 20;
constexpr size_t WS_WD = WS_WGU + 4 * SZ_WGU;
constexpr size_t WS_WIN = WS_WD + 4 * SZ_WD;
constexpr size_t WS_WOUT = WS_WIN + 2 * SZ_WIN;
constexpr size_t WS_SGUW = WS_WOUT + 2 * SZ_WOUT;
constexpr size_t WS_RGW = WS_SGUW + 2 * SZ_SGUW;
constexpr size_t WS_XB = WS_RGW + 2 * SZ_RGW;
constexpr size_t WS_HZ = WS_XB + (size_t)T * D * 2;
constexpr size_t WS_Y = WS_HZ + (size_t)T * FF * 2;
constexpr size_t WS_BAR = WS_Y + (size_t)T * D * 2;
constexpr size_t WS_ST = WS_BAR + 16384;
constexpr size_t WS_END = WS_ST + 6 * (size_t)T * 2 * 4;

struct Params { const float* in[20]; float* out; unsigned char* ws; int ph_lo, ph_hi; };


__device__ __forceinline__ const float* inptr(LAS unsigned char* lds, int i) {
    const u32x2 v = *(LAS const u32x2*)(lds + LDS_PTAB + 8 * i);
    const unsigned long long a = ((unsigned long long)(unsigned)__builtin_amdgcn_readfirstlane((int)v.y) << 32) | (unsigned)__builtin_amdgcn_readfirstlane((int)v.x);
    return (const float*)a;
}

__device__ __forceinline__ float sigmoid_f(float x) { return __builtin_amdgcn_rcpf(1.0f + __builtin_amdgcn_exp2f(-1.4426950408889634f * x)); }
__device__ __forceinline__ float gelu_f(float x) { return x * sigmoid_f(1.5957691216057308f * x * (1.0f + 0.044715f * x * x)); }
__device__ __forceinline__ float bf_lo(unsigned w) { return __uint_as_float(w << 16); }
__device__ __forceinline__ float bf_hi(unsigned w) { return __uint_as_float(w & 0xffff0000u); }
__device__ __forceinline__ unsigned pk_bf16(float lo, float hi) { return pg8::cvt_pk_bf16(lo, hi); }
__device__ __forceinline__ float wave_sum(float v) {
    v += __builtin_bit_cast(float, __builtin_amdgcn_update_dpp(0, __builtin_bit_cast(int, v), 0xB1, 0xF, 0xF, true));
    v += __builtin_bit_cast(float, __builtin_amdgcn_update_dpp(0, __builtin_bit_cast(int, v), 0x4E, 0xF, 0xF, true));
    v += __builtin_bit_cast(float, __builtin_amdgcn_update_dpp(0, __builtin_bit_cast(int, v), 0x141, 0xF, 0xF, true));
    v += __builtin_bit_cast(float, __builtin_amdgcn_update_dpp(0, __builtin_bit_cast(int, v), 0x140, 0xF, 0xF, true));
    v += __shfl_xor(v, 16); v += __shfl_xor(v, 32);
    return v;
}

struct EpiSwiGLU {
    static constexpr bool PERM = true, AFTER_DRAIN = false;
    bf16_t* O;
    __device__ __forceinline__ void operator()(const f32x4 (&acc)[2][2][4][2], const pg8::Unit& u, int wr, int wc, int fr, int fq) const {
        const int row0 = u.pm * 256 + wr * 64 + fr, col0 = u.pn * 128 + wc * 32 + 8 * fq;
#pragma unroll
        for (int ai = 0; ai < 2; ++ai)
#pragma unroll
            for (int m = 0; m < 4; ++m) {
                bf16_t* rowp = O + (size_t)(row0 + ai * 128 + m * 16) * FF + col0;
                const f32x4 g0 = acc[ai][0][m][0], g1 = acc[ai][0][m][1], u0 = acc[ai][1][m][0], u1 = acc[ai][1][m][1];
                float h[8];
#pragma unroll
                for (int j = 0; j < 4; ++j) { h[j] = g0[j] * sigmoid_f(g0[j]) * u0[j]; h[4 + j] = g1[j] * sigmoid_f(g1[j]) * u1[j]; }
                u32x4 w; w.x = pk_bf16(h[0], h[1]); w.y = pk_bf16(h[2], h[3]); w.z = pk_bf16(h[4], h[5]); w.w = pk_bf16(h[6], h[7]);
                *(u32x4*)rowp = w;
            }
    }
};
typedef float f32x2 __attribute__((ext_vector_type(2)));
constexpr int LDS_GB = 131072;
struct EpiRes {
    static constexpr bool PERM = true, AFTER_DRAIN = false;
    const float* res; float* out; float scale; const float* St; LAS const float* lgb;
    __device__ __forceinline__ void operator()(const f32x4 (&acc)[2][2][4][2], const pg8::Unit& u, int wr, int wc, int fr, int fq) const {
        const int row0 = u.pm * 256 + wr * 64 + fr, col0 = u.pn * 256 + wc * 32 + 8 * fq;
        const bool has = St != nullptr; const float* st2 = has ? St : res;
#pragma unroll
        for (int ai = 0; ai < 2; ++ai) {
            f32x4 r[4][2][2]; f32x2 st[4];
#pragma unroll
            for (int e = 0; e < 4; ++e) { const int row = row0 + ai * 128 + e * 16; const size_t off = (size_t)row * D + col0;
                st[e] = *(const f32x2*)(st2 + 2 * (size_t)row);
#pragma unroll
                for (int bj = 0; bj < 2; ++bj)
#pragma unroll
                    for (int n = 0; n < 2; ++n) r[e][bj][n] = *(const f32x4*)(res + off + bj * 128 + n * 4); }
#pragma unroll
            for (int e = 0; e < 4; ++e) if (!has) st[e] = (f32x2){0.f, 1.f};
#pragma unroll
            for (int bj = 0; bj < 2; ++bj)
#pragma unroll
                for (int n = 0; n < 2; ++n) { const f32x4 gv = *(LAS const f32x4*)(lgb + col0 + bj * 128 + n * 4), bv = *(LAS const f32x4*)(lgb + 1024 + col0 + bj * 128 + n * 4);
#pragma unroll
                    for (int e = 0; e < 4; ++e) { const size_t off = (size_t)(row0 + ai * 128 + e * 16) * D + col0;
                        const f32x4 xh = (r[e][bj][n] - st[e].x) * st[e].y * gv + bv;
                        *(f32x4*)(out + off + bj * 128 + n * 4) = ALPHA * xh + scale * acc[ai][bj][e][n]; } }
            asm volatile("" ::: "memory");
        }
    }
};
struct EpiBf16 {
    static constexpr bool PERM = true, AFTER_DRAIN = false;
    bf16_t* O; int ldc;
    __device__ __forceinline__ void operator()(const f32x4 (&acc)[2][2][4][2], const pg8::Unit& u, int wr, int wc, int fr, int fq) const {
        const int row0 = u.pm * 256 + wr * 64 + fr, col0 = u.pn * 256 + wc * 32 + 8 * fq;
#pragma unroll
        for (int ai = 0; ai < 2; ++ai)
#pragma unroll
            for (int m = 0; m < 4; ++m) {
                bf16_t* rowp = O + (size_t)(row0 + ai * 128 + m * 16) * ldc + col0;
#pragma unroll
                for (int bj = 0; bj < 2; ++bj) { const f32x4 v0 = acc[ai][bj][m][0], v1 = acc[ai][bj][m][1];
                    u32x4 w; w.x = pk_bf16(v0[0], v0[1]); w.y = pk_bf16(v0[2], v0[3]); w.z = pk_bf16(v1[0], v1[1]); w.w = pk_bf16(v1[2], v1[3]);
                    *(u32x4*)(rowp + bj * 128) = w; }
            }
    }
};


struct EpiAny {
    static constexpr bool PERM = true, AFTER_DRAIN = false;
    int mode; bf16_t* O; int ldc; const float* res; float* out; float scale; const float* St; LAS const float* lgb;
    __device__ __forceinline__ void operator()(const f32x4 (&acc)[2][2][4][2], const pg8::Unit& u, int wr, int wc, int fr, int fq) const {
        if (mode == 0) { EpiSwiGLU e{O}; e(acc, u, wr, wc, fr, fq); }
        else if (mode == 1) { EpiRes e{res, out, scale, St, lgb}; e(acc, u, wr, wc, fr, fq); }
        else { EpiBf16 e{O, ldc}; e(acc, u, wr, wc, fr, fq); }
    }
};

__device__ __forceinline__ void prologue_phase(unsigned char* ws, LAS unsigned char* lds, const int tid) {
    LAS float* tile = (LAS float*)lds;
    for (int jb = blockIdx.x * 4; jb < 10112; jb += gridDim.x * 4) {
        float lv[4][8];
#pragma unroll
        for (int u = 0; u < 4; ++u) {
            const int j = jb + u; const float* src; int N, t;
            if (j < 5632) { const int m = j / 704; t = j % 704; N = FF; src = inptr(lds, (m & 1) ? 4 : 3) + (size_t)(m >> 1) * D * FF; }
            else if (j < 8448) { const int j2 = j - 5632; t = j2 % 704; N = D; src = inptr(lds, 5) + (size_t)(j2 / 704) * FF * D; }
            else if (j < 9600) { const int j3 = j - 8448; t = j3 % 576; N = NIN; src = inptr(lds, 6) + (size_t)(j3 / 576) * D * NIN; }
            else { const int j4 = j - 9600; t = j4 % 256; N = D; src = inptr(lds, 19) + (size_t)(j4 / 256) * D * D; }
            const int ntn = N / 64, k0 = (t / ntn) * 64, n0 = (t % ntn) * 64;
#pragma unroll
            for (int it = 0; it < 8; ++it) lv[u][it] = src[(size_t)(k0 + it * 8 + (tid >> 6)) * N + n0 + (tid & 63)];
        }
#pragma unroll
        for (int u = 0; u < 4; ++u)
#pragma unroll
            for (int it = 0; it < 8; ++it) tile[u * 4160 + (it * 8 + (tid >> 6)) * 65 + (tid & 63)] = lv[u][it];
        __syncthreads();
#pragma unroll
        for (int u = 0; u < 4; ++u) {
            const int j = jb + u; bf16_t* dst; int K, N, which = -1, t;
            if (j < 5632) { const int m = j / 704; t = j % 704; which = m & 1; K = D; N = FF; dst = (bf16_t*)(ws + WS_WGU + (size_t)(m >> 1) * SZ_WGU); }
            else if (j < 8448) { const int j2 = j - 5632; t = j2 % 704; K = FF; N = D; dst = (bf16_t*)(ws + WS_WD + (size_t)(j2 / 704) * SZ_WD); }
            else if (j < 9600) { const int j3 = j - 8448; t = j3 % 576; K = D; N = NIN; dst = (bf16_t*)(ws + WS_WIN + (size_t)(j3 / 576) * SZ_WIN); }
            else { const int j4 = j - 9600; t = j4 % 256; K = D; N = D; dst = (bf16_t*)(ws + WS_WOUT + (size_t)(j4 / 256) * SZ_WOUT); }
            const int ntn = N / 64, k0 = (t / ntn) * 64, n0 = (t % ntn) * 64;
            const int kp = tid & 31, jq = tid >> 5;
#pragma unroll
            for (int it = 0; it < 4; ++it) { const int jj = it * 16 + jq, n = n0 + jj; const int rho = which < 0 ? n : (256 * (n >> 7) + 128 * which + (n & 127));
                *(unsigned*)(dst + (size_t)rho * K + k0 + 2 * kp) = pk_bf16(tile[u * 4160 + (2 * kp) * 65 + jj], tile[u * 4160 + (2 * kp + 1) * 65 + jj]); }
        }
        __syncthreads();
    }
    const size_t gtid = (size_t)blockIdx.x * 512 + tid, gsz = (size_t)gridDim.x * 512;
    { const float* x = inptr(lds, 0); bf16_t* xb = (bf16_t*)(ws + WS_XB);
      for (size_t v = gtid; v < (size_t)T * D / 8; v += gsz) { const f32x4 a = *(const f32x4*)(x + v * 8), b = *(const f32x4*)(x + v * 8 + 4);
          u32x4 w; w.x = pk_bf16(a[0], a[1]); w.y = pk_bf16(a[2], a[3]); w.z = pk_bf16(b[0], b[1]); w.w = pk_bf16(b[2], b[3]); *(u32x4*)(xb + v * 8) = w; } }
    for (size_t i = gtid; i < 2 * 4 * 128 * 128; i += gsz) { const int s = (int)(i & 127), tt = (int)((i >> 7) & 127); const float v = s <= tt ? inptr(lds, 9)[i] : 0.f;
        ((bf16_t*)(ws + WS_SGUW))[i] = (bf16_t)(pk_bf16(v, 0.f) & 0xffffu); }
    for (size_t i = gtid; i < 2 * 2 * 8 * 64 * 64; i += gsz) { const int d = (int)(i & 63), e = (int)((i >> 6) & 63), h = (int)((i >> 12) & 7), g = (int)((i >> 15) & 1), l = (int)(i >> 16);
        const float v = inptr(lds, g ? 16 : 14)[(((size_t)l * 8 + h) * 64 + d) * 64 + e];
        ((bf16_t*)(ws + WS_RGW))[i] = (bf16_t)(pk_bf16(v, 0.f) & 0xffffu); }
}

__device__ __forceinline__ void ln_phase(float* X, bf16_t* XB, float* St, const bool fin, const float* g, const float* b, const int tid) {
    const int lane = tid & 63, wid = tid >> 6;
    f32x4 gv[4], bv[4];
#pragma unroll
    for (int i = 0; i < 4; ++i) { gv[i] = *(const f32x4*)(g + 4 * lane + 256 * i); bv[i] = *(const f32x4*)(b + 4 * lane + 256 * i); }
    for (int r0 = (blockIdx.x * 8 + wid) * 4; r0 < T; r0 += gridDim.x * 32) {
        f32x4 v[4][4];
#pragma unroll
        for (int rr = 0; rr < 4; ++rr)
#pragma unroll
            for (int i = 0; i < 4; ++i) v[rr][i] = *(const f32x4*)(X + (size_t)(r0 + rr) * D + 4 * lane + 256 * i);
        float s[4], q[4];
#pragma unroll
        for (int rr = 0; rr < 4; ++rr) { s[rr] = 0.f;
#pragma unroll
            for (int i = 0; i < 4; ++i) s[rr] += (v[rr][i][0] + v[rr][i][1]) + (v[rr][i][2] + v[rr][i][3]); }
#pragma unroll
        for (int o = 32; o >= 1; o >>= 1)
#pragma unroll
            for (int rr = 0; rr < 4; ++rr) s[rr] += __shfl_xor(s[rr], o);
#pragma unroll
        for (int rr = 0; rr < 4; ++rr) { const float mean = s[rr] * (1.0f / D); q[rr] = 0.f;
#pragma unroll
            for (int i = 0; i < 4; ++i) { v[rr][i] -= mean; q[rr] += (v[rr][i][0] * v[rr][i][0] + v[rr][i][1] * v[rr][i][1]) + (v[rr][i][2] * v[rr][i][2] + v[rr][i][3] * v[rr][i][3]); } }
#pragma unroll
        for (int o = 32; o >= 1; o >>= 1)
#pragma unroll
            for (int rr = 0; rr < 4; ++rr) q[rr] += __shfl_xor(q[rr], o);
#pragma unroll
        for (int rr = 0; rr < 4; ++rr) { const float rstd = rsqrtf(q[rr] * (1.0f / D) + LN_EPS);
            float* xr = X + (size_t)(r0 + rr) * D + 4 * lane; bf16_t* xbr = XB + (size_t)(r0 + rr) * D + 4 * lane;
            if (!fin && lane == 0) *(f32x2*)(St + 2 * (size_t)(r0 + rr)) = (f32x2){s[rr] * (1.0f / D), rstd};
#pragma unroll
            for (int i = 0; i < 4; ++i) { const f32x4 y = v[rr][i] * rstd * gv[i] + bv[i];
                if (fin) *(f32x4*)(xr + 256 * i) = y;
                else { u32x2 w; w.x = pk_bf16(y[0], y[1]); w.y = pk_bf16(y[2], y[3]); *(u32x2*)(xbr + 256 * i) = w; } } }
    }
}

struct MixP { const bf16_t* Z; bf16_t* Y; float* agg; const bf16_t* sguw; const bf16_t* rgw;
    const float *sgu_ln_g, *sgu_ln_b, *sgu_b, *sconv_w, *rg_conv_w, *rg_conv_b, *rg_b_a, *rg_b_i, *rg_lambda; };
constexpr int VT_PITCH = 136;
constexpr int LDS_VT = 0;
constexpr int LDS_RG = 69632;
constexpr int LDS_CONST = 139264;

__device__ __forceinline__ void mix_consts(const MixP& mp, LAS unsigned char* lds, const int tid) {
    LAS float* CW = (LAS float*)(lds + LDS_CONST);
    for (int i = tid; i < 2048; i += 512) CW[i] = mp.rg_conv_w[i];
    CW[2048 + tid] = mp.rg_conv_b[tid]; CW[2560 + tid] = mp.rg_b_a[tid]; CW[3072 + tid] = mp.rg_b_i[tid];
    CW[3584 + tid] = 8.0f * log1pf(expf(-mp.rg_lambda[tid]));
    __syncthreads();
}

template <bool FULL>
__device__ __forceinline__ void rg_tile(const MixP& mp, int tile, LAS unsigned char* lds, int wid, int lane, float carry) {
    const int fr = lane & 15, fq = lane >> 4, h = wid;
    const int t0 = tile * 128, seq0 = (tile >> 7) << 14;
    LAS float* P0 = (LAS float*)(lds + LDS_RG + wid * 8704); LAS float* P1 = P0 + 16 * 68;
    LAS const float* CW = (LAS const float*)(lds + LDS_CONST);
    bf16x8 wf[2][2][4];
#pragma unroll
    for (int g = 0; g < 2; ++g)
#pragma unroll
        for (int ks = 0; ks < 2; ++ks)
#pragma unroll
            for (int n = 0; n < 4; ++n) wf[g][ks][n] = *(const bf16x8*)(mp.rgw + ((size_t)((g * 8 + h) * 64 + 16 * n + fr) * 64 + 32 * ks + 8 * fq));
    float hst = carry, ap = 1.0f;
    const bf16_t* zx = mp.Z + 1792 + 64 * h + 8 * fq;
    const int cbase = 64 * h + 8 * fq;
    u32x4 own_prev[2], own_cur[2], own_next[2];
    { const int tp = t0 - 16 + fr; const bool ok = tp >= seq0;
#pragma unroll
      for (int ks = 0; ks < 2; ++ks) { own_prev[ks] = ok ? *(const u32x4*)(zx + (size_t)tp * NIN + 32 * ks) : (u32x4){0u, 0u, 0u, 0u}; own_cur[ks] = *(const u32x4*)(zx + (size_t)(t0 + fr) * NIN + 32 * ks); own_next[ks] = own_cur[ks]; } }
    for (int g = 0; g < 8; ++g) {
        if (g < 7) {
#pragma unroll
            for (int ks = 0; ks < 2; ++ks) own_next[ks] = *(const u32x4*)(zx + (size_t)(t0 + 16 * (g + 1) + fr) * NIN + 32 * ks);
        }
        bf16x8 xa[2];
#pragma unroll
        for (int ks = 0; ks < 2; ++ks) {
            f32x4 c0 = *(LAS const f32x4*)(CW + 2048 + cbase + 32 * ks), c1 = *(LAS const f32x4*)(CW + 2048 + cbase + 32 * ks + 4);
#pragma unroll
            for (int k = 0; k < 4; ++k) { const f32x4 w0 = *(LAS const f32x4*)(CW + k * 512 + cbase + 32 * ks), w1 = *(LAS const f32x4*)(CW + k * 512 + cbase + 32 * ks + 4);
                u32x4 x;
                if (k == 3) x = own_cur[ks];
                else {
#define ROR(v, K) (unsigned)__builtin_amdgcn_update_dpp(0, (int)(v), 0x120 + (K), 0xF, 0xF, false)
                    const u32x4 c = own_cur[ks], p = own_prev[ks]; u32x4 rc, rp;
                    if (k == 2) { rc.x = ROR(c.x, 1); rc.y = ROR(c.y, 1); rc.z = ROR(c.z, 1); rc.w = ROR(c.w, 1); rp.x = ROR(p.x, 1); rp.y = ROR(p.y, 1); rp.z = ROR(p.z, 1); rp.w = ROR(p.w, 1); }
                    else if (k == 1) { rc.x = ROR(c.x, 2); rc.y = ROR(c.y, 2); rc.z = ROR(c.z, 2); rc.w = ROR(c.w, 2); rp.x = ROR(p.x, 2); rp.y = ROR(p.y, 2); rp.z = ROR(p.z, 2); rp.w = ROR(p.w, 2); }
                    else { rc.x = ROR(c.x, 3); rc.y = ROR(c.y, 3); rc.z = ROR(c.z, 3); rc.w = ROR(c.w, 3); rp.x = ROR(p.x, 3); rp.y = ROR(p.y, 3); rp.z = ROR(p.z, 3); rp.w = ROR(p.w, 3); }
#undef ROR
                    const bool cur = fr >= 3 - k;
                    x.x = cur ? rc.x : rp.x; x.y = cur ? rc.y : rp.y; x.z = cur ? rc.z : rp.z; x.w = cur ? rc.w : rp.w;
                }
                c0[0] += w0[0] * bf_lo(x.x); c0[1] += w0[1] * bf_hi(x.x); c0[2] += w0[2] * bf_lo(x.y); c0[3] += w0[3] * bf_hi(x.y);
                c1[0] += w1[0] * bf_lo(x.z); c1[1] += w1[1] * bf_hi(x.z); c1[2] += w1[2] * bf_lo(x.w); c1[3] += w1[3] * bf_hi(x.w); }
            *(LAS f32x4*)(P0 + fr * 68 + 32 * ks + 8 * fq) = c0; *(LAS f32x4*)(P0 + fr * 68 + 32 * ks + 8 * fq + 4) = c1;
            u32x4 pk; pk.x = pk_bf16(c0[0], c0[1]); pk.y = pk_bf16(c0[2], c0[3]); pk.z = pk_bf16(c1[0], c1[1]); pk.w = pk_bf16(c1[2], c1[3]);
            xa[ks] = __builtin_bit_cast(bf16x8, pk);
        }
#pragma unroll
        for (int ks = 0; ks < 2; ++ks) { own_prev[ks] = own_cur[ks]; own_cur[ks] = own_next[ks]; }
        f32x4 ar[4], ai[4];
#pragma unroll
        for (int n = 0; n < 4; ++n) { ar[n] = (f32x4){0.f, 0.f, 0.f, 0.f}; ai[n] = (f32x4){0.f, 0.f, 0.f, 0.f};
#pragma unroll
            for (int ks = 0; ks < 2; ++ks) { ar[n] = __builtin_amdgcn_mfma_f32_16x16x32_bf16(wf[0][ks][n], xa[ks], ar[n], 0, 0, 0); ai[n] = __builtin_amdgcn_mfma_f32_16x16x32_bf16(wf[1][ks][n], xa[ks], ai[n], 0, 0, 0); } }
        asm volatile("s_waitcnt lgkmcnt(0)" ::: "memory");
        f32x4 av[4], bv[4];
#pragma unroll
        for (int n = 0; n < 4; ++n) { const int e = 64 * h + 16 * n + 4 * fq;
            const f32x4 ba = *(LAS const f32x4*)(CW + 2560 + e), bi = *(LAS const f32x4*)(CW + 3072 + e), sp = *(LAS const f32x4*)(CW + 3584 + e), xc = *(LAS const f32x4*)(P0 + fr * 68 + 16 * n + 4 * fq);
#pragma unroll
            for (int j = 0; j < 4; ++j) { const float r = sigmoid_f(ar[n][j] + ba[j]), ig = sigmoid_f(ai[n][j] + bi[j]);
                const float a = __builtin_amdgcn_exp2f(-1.4426950408889634f * r * sp[j]); const float m2 = fmaxf(1.0f - a * a, 0.0f);
                av[n][j] = a; bv[n][j] = __builtin_amdgcn_sqrtf(m2) * (ig * xc[j]); } }
        asm volatile("s_waitcnt lgkmcnt(0)" ::: "memory");
#pragma unroll
        for (int n = 0; n < 4; ++n) { *(LAS f32x4*)(P0 + fr * 68 + 16 * n + 4 * fq) = av[n]; *(LAS f32x4*)(P1 + fr * 68 + 16 * n + 4 * fq) = bv[n]; }
        asm volatile("s_waitcnt lgkmcnt(0)" ::: "memory");
#pragma unroll
        for (int t = 0; t < 16; ++t) { const float a = P0[t * 68 + lane], b = P1[t * 68 + lane]; hst = a * hst + b; if (!FULL) ap *= a; if (FULL) P1[t * 68 + lane] = hst; }
        if (FULL) {
            asm volatile("s_waitcnt lgkmcnt(0)" ::: "memory");
#pragma unroll
            for (int it = 0; it < 2; ++it) { const int tkn = it * 8 + (lane >> 3), c8 = (lane & 7) * 8; const size_t tg = (size_t)(t0 + 16 * g + tkn);
                const f32x4 h0 = *(LAS const f32x4*)(P1 + tkn * 68 + c8), h1 = *(LAS const f32x4*)(P1 + tkn * 68 + c8 + 4);
                const u32x4 gt = *(const u32x4*)(mp.Z + tg * NIN + 1280 + 64 * h + c8);
                u32x4 w; w.x = pk_bf16(gelu_f(bf_lo(gt.x)) * h0[0], gelu_f(bf_hi(gt.x)) * h0[1]); w.y = pk_bf16(gelu_f(bf_lo(gt.y)) * h0[2], gelu_f(bf_hi(gt.y)) * h0[3]);
                w.z = pk_bf16(gelu_f(bf_lo(gt.z)) * h1[0], gelu_f(bf_hi(gt.z)) * h1[1]); w.w = pk_bf16(gelu_f(bf_lo(gt.w)) * h1[2], gelu_f(bf_hi(gt.w)) * h1[3]);
                *(u32x4*)(mp.Y + tg * D + 512 + 64 * h + c8) = w; }
            asm volatile("s_waitcnt lgkmcnt(0)" ::: "memory");
        }
    }
    if (!FULL) { mp.agg[(size_t)tile * 1024 + 64 * h + lane] = ap; mp.agg[(size_t)tile * 1024 + 512 + 64 * h + lane] = hst; }
}

__device__ __forceinline__ void mix1_phase(const MixP& mp, LAS unsigned char* lds, const int tid) {
    const int lane = tid & 63, wid = __builtin_amdgcn_readfirstlane(tid >> 6);
    mix_consts(mp, lds, tid);
    for (int tile = blockIdx.x; tile < 256; tile += gridDim.x) rg_tile<false>(mp, tile, lds, wid, lane, 0.0f);
}

__device__ __forceinline__ void mix2_phase(const MixP& mp, LAS unsigned char* lds, const int tid) {
    const int lane = tid & 63, wid = __builtin_amdgcn_readfirstlane(tid >> 6), fr = lane & 15, fq = lane >> 4;
    mix_consts(mp, lds, tid);
    LAS bf16_t* VT = (LAS bf16_t*)(lds + LDS_VT);
    for (int tile = blockIdx.x; tile < 256; tile += gridDim.x) {
        const int t0 = tile * 128, seq0 = (tile >> 7) << 14;
        {
            const f32x4 gch = *(const f32x4*)(mp.sgu_ln_g + 4 * lane), bch = *(const f32x4*)(mp.sgu_ln_b + 4 * lane);
            u32x2 raw[16];
#pragma unroll
            for (int i = 0; i < 16; ++i) raw[i] = *(const u32x2*)(mp.Z + (size_t)(t0 + 16 * wid + i) * NIN + 256 + 4 * lane);
            unsigned wv[4][8];
#pragma unroll
            for (int i2 = 0; i2 < 8; ++i2) {
                f32x4 vn[2];
#pragma unroll
                for (int e = 0; e < 2; ++e) { const u32x2 rw = raw[2 * i2 + e];
                    f32x4 v = {gelu_f(bf_lo(rw.x)), gelu_f(bf_hi(rw.x)), gelu_f(bf_lo(rw.y)), gelu_f(bf_hi(rw.y))};
                    const float mean = wave_sum((v[0] + v[1]) + (v[2] + v[3])) * (1.0f / 256.0f);
                    v -= mean;
                    const float rstd = rsqrtf(wave_sum((v[0] * v[0] + v[1] * v[1]) + (v[2] * v[2] + v[3] * v[3])) * (1.0f / 256.0f) + LN_EPS);
                    vn[e] = v * rstd * gch + bch; }
#pragma unroll
                for (int q = 0; q < 4; ++q) wv[q][i2] = pk_bf16(vn[0][q], vn[1][q]);
            }
#pragma unroll
            for (int q = 0; q < 4; ++q)
#pragma unroll
                for (int hf = 0; hf < 2; ++hf) { u32x4 w; w.x = wv[q][4 * hf]; w.y = wv[q][4 * hf + 1]; w.z = wv[q][4 * hf + 2]; w.w = wv[q][4 * hf + 3];
                    *(LAS u32x4*)(VT + (4 * lane + q) * VT_PITCH + 16 * wid + 8 * hf) = w; }
        }
        __syncthreads();
        {
            const int hd = wid >> 1, th = wid & 1;
            bf16x8 vf[4][4];
#pragma unroll
            for (int n = 0; n < 4; ++n)
#pragma unroll
                for (int ks = 0; ks < 4; ++ks) vf[n][ks] = *(LAS const bf16x8*)(VT + (64 * hd + 16 * n + fr) * VT_PITCH + 32 * ks + 8 * fq);
#pragma unroll
            for (int m = 0; m < 4; ++m) {
                const int trow = 64 * th + 16 * m + fr;
                bf16x8 wfr[4];
#pragma unroll
                for (int ks = 0; ks < 4; ++ks) wfr[ks] = *(const bf16x8*)(mp.sguw + ((size_t)(hd * 128 + trow) * 128 + 32 * ks + 8 * fq));
                f32x4 acc[4];
#pragma unroll
                for (int n = 0; n < 4; ++n) { acc[n] = (f32x4){0.f, 0.f, 0.f, 0.f};
#pragma unroll
                    for (int ks = 0; ks < 4; ++ks) acc[n] = __builtin_amdgcn_mfma_f32_16x16x32_bf16(vf[n][ks], wfr[ks], acc[n], 0, 0, 0); }
                const float bs = mp.sgu_b[hd * 128 + trow];
                const size_t tg = (size_t)(t0 + trow);
#pragma unroll
                for (int n = 0; n < 4; ++n) { const int c = 64 * hd + 16 * n + 4 * fq; const u32x2 uu = *(const u32x2*)(mp.Z + tg * NIN + c);
                    u32x2 w; w.x = pk_bf16(gelu_f(bf_lo(uu.x)) * (acc[n][0] + bs), gelu_f(bf_hi(uu.x)) * (acc[n][1] + bs));
                    w.y = pk_bf16(gelu_f(bf_lo(uu.y)) * (acc[n][2] + bs), gelu_f(bf_hi(uu.y)) * (acc[n][3] + bs));
                    *(u32x2*)(mp.Y + tg * D + c) = w; }
            }
        }
#pragma unroll 2
        for (int it = 0; it < 8; ++it) {
            const int item = tid + 512 * it, tkl = item >> 5, c8 = (item & 31) * 8, tok = t0 + tkl;
            const u32x4 bg = *(const u32x4*)(mp.Z + (size_t)tok * NIN + 512 + c8);
            float acc[8];
#pragma unroll
            for (int i = 0; i < 8; ++i) acc[i] = 0.f;
#pragma unroll
            for (int k = 0; k < 3; ++k) { const int tk = tok - 2 + k;
                if (tk >= seq0) { const u32x4 cgv = *(const u32x4*)(mp.Z + (size_t)tk * NIN + 768 + c8), xi = *(const u32x4*)(mp.Z + (size_t)tk * NIN + 1024 + c8);
                    const f32x4 w0 = *(const f32x4*)(mp.sconv_w + k * 256 + c8), w1 = *(const f32x4*)(mp.sconv_w + k * 256 + c8 + 4);
                    acc[0] += w0[0] * (bf_lo(cgv.x) * bf_lo(xi.x)); acc[1] += w0[1] * (bf_hi(cgv.x) * bf_hi(xi.x)); acc[2] += w0[2] * (bf_lo(cgv.y) * bf_lo(xi.y)); acc[3] += w0[3] * (bf_hi(cgv.y) * bf_hi(xi.y));
                    acc[4] += w1[0] * (bf_lo(cgv.z) * bf_lo(xi.z)); acc[5] += w1[1] * (bf_hi(cgv.z) * bf_hi(xi.z)); acc[6] += w1[2] * (bf_lo(cgv.w) * bf_lo(xi.w)); acc[7] += w1[3] * (bf_hi(cgv.w) * bf_hi(xi.w)); } }
            u32x4 w; w.x = pk_bf16(bf_lo(bg.x) * acc[0], bf_hi(bg.x) * acc[1]); w.y = pk_bf16(bf_lo(bg.y) * acc[2], bf_hi(bg.y) * acc[3]);
            w.z = pk_bf16(bf_lo(bg.z) * acc[4], bf_hi(bg.z) * acc[5]); w.w = pk_bf16(bf_lo(bg.w) * acc[6], bf_hi(bg.w) * acc[7]);
            *(u32x4*)(mp.Y + (size_t)tok * D + 256 + c8) = w;
        }
        {
            const int pt = tile & 127, tb = tile - pt, ch = 64 * wid + lane; float c = 0.f;
            const float* ag = mp.agg + (size_t)tb * 1024 + ch; int q = 0;
            for (; q + 32 <= pt; q += 32) { float av[32], hv[32];
#pragma unroll
                for (int i = 0; i < 32; ++i) { av[i] = ag[(size_t)(q + i) * 1024]; hv[i] = ag[(size_t)(q + i) * 1024 + 512]; }
#pragma unroll
                for (int i = 0; i < 32; ++i) c = av[i] * c + hv[i]; }
            for (; q + 8 <= pt; q += 8) { float av[8], hv[8];
#pragma unroll
                for (int i = 0; i < 8; ++i) { av[i] = ag[(size_t)(q + i) * 1024]; hv[i] = ag[(size_t)(q + i) * 1024 + 512]; }
#pragma unroll
                for (int i = 0; i < 8; ++i) c = av[i] * c + hv[i]; }
            for (; q < pt; ++q) c = ag[(size_t)q * 1024] * c + ag[(size_t)q * 1024 + 512];
            rg_tile<true>(mp, tile, lds, wid, lane, c);
        }
        __syncthreads();
    }
}

__global__ void __launch_bounds__(512, 2) mega(Params p) {
    extern __shared__ __attribute__((aligned(16))) unsigned char lds_raw[];
    LAS unsigned char* lds = (LAS unsigned char*)lds_raw;
    cg::grid_group grid = cg::this_grid();
    if (threadIdx.x == 0) {
        LAS unsigned long long* pt = (LAS unsigned long long*)(lds + LDS_PTAB);
#define PT(i) pt[i] = (unsigned long long)p.in[i];
        PT(0) PT(1) PT(2) PT(3) PT(4) PT(5) PT(6) PT(7) PT(8) PT(9) PT(10) PT(11) PT(12) PT(13) PT(14) PT(15) PT(16) PT(17) PT(18) PT(19)
#undef PT
    }
    volatile LAS unsigned* bst = (volatile LAS unsigned*)(lds + LDS_PTAB + 256);
    if (threadIdx.x < 4) bst[threadIdx.x] = 0u;
    unsigned* barw = (unsigned*)(p.ws + WS_BAR);
    if (blockIdx.x == 0) for (int i = threadIdx.x; i < XCD_BAR_WORDS; i += 512) barw[i] = 0u;
    __syncthreads();
    XcdBarrier xb; xb.bar = barw; xb.x = 0; xb.st = bst;
    for (int ph = p.ph_lo; ph < p.ph_hi; ++ph) {
        unsigned char* ws = p.ws; float* outp = p.out; int tid = threadIdx.x;
        asm volatile("" : "+s"(ws), "+s"(outp), "+v"(tid));
        bf16_t* XB = (bf16_t*)(ws + WS_XB); bf16_t* HZ = (bf16_t*)(ws + WS_HZ); bf16_t* Y = (bf16_t*)(ws + WS_Y);
#ifndef NO_PRO
        if (ph == 0) prologue_phase(ws, lds, tid);
        else
#endif
        {
            const int l = (ph - 1) / 11, q = (ph - 1) % 11;
            if (q == 2 || q == 7 || q == 10) {
                const int k = q == 2 ? 0 : (q == 7 ? 1 : 2);
#ifndef NO_LN
                ln_phase(outp, XB, (float*)(ws + WS_ST) + (size_t)(l * 3 + k) * T * 2, ph == NPHASE - 1, inptr(lds, 1) + (size_t)(l * 3 + k) * D, inptr(lds, 2) + (size_t)(l * 3 + k) * D, tid);
#endif
            } else if (q != 4 && q != 5) {
                pg8::Gemm g; EpiAny E{};
                if (q == 0 || q == 8) {
                    const int lf = l * 2 + (q == 8);
                    g = pg8::Gemm{XB, (const bf16_t*)(ws + WS_WGU + (size_t)lf * SZ_WGU), T, NGU, D}; E.mode = 0; E.O = HZ; E.ldc = FF;
                } else if (q == 3) {
                    g = pg8::Gemm{XB, (const bf16_t*)(ws + WS_WIN + (size_t)l * SZ_WIN), T, NIN, D}; E.mode = 2; E.O = HZ; E.ldc = NIN;
                } else {
                    E.mode = 1; E.res = (l == 0 && q == 1) ? inptr(lds, 0) : outp; E.out = outp;
                    const int lp = q == 1 ? 3 * l - 1 : (q == 6 ? 3 * l : 3 * l + 1);
                    LAS float* lgb = (LAS float*)(lds + LDS_GB); E.lgb = lgb;
                    if (lp >= 0) { E.St = (const float*)(ws + WS_ST) + (size_t)lp * T * 2; const float* gp = inptr(lds, 1) + (size_t)lp * D; const float* bp = inptr(lds, 2) + (size_t)lp * D;
                        for (int i = tid; i < D; i += 512) { lgb[i] = gp[i]; lgb[D + i] = bp[i]; } }
                    else { for (int i = tid; i < D; i += 512) { lgb[i] = 1.0f; lgb[D + i] = 0.0f; } }
                    __syncthreads();
                    if (q == 6) { g = pg8::Gemm{Y, (const bf16_t*)(ws + WS_WOUT + (size_t)l * SZ_WOUT), T, D, D}; E.scale = 1.0f; }
                    else { const int lf = l * 2 + (q == 9); g = pg8::Gemm{HZ, (const bf16_t*)(ws + WS_WD + (size_t)lf * SZ_WD), T, D, FF}; E.scale = 0.5f; }
                }
                pg8::StaticOrder S; S.init(g.M, g.N, gridDim.x, blockIdx.x);
#ifndef NO_G1
                pg8::gemm_phase<EpiAny, pg8::StaticOrder>(lds, g, S, E, nullptr, tid);
#endif
            } else {
                MixP mp{HZ, Y, (float*)(ws + WS_AGG), (const bf16_t*)(ws + WS_SGUW + (size_t)l * SZ_SGUW), (const bf16_t*)(ws + WS_RGW + (size_t)l * SZ_RGW),
                        inptr(lds, 7) + l * 256, inptr(lds, 8) + l * 256, inptr(lds, 10) + l * 512, inptr(lds, 11) + l * 768, inptr(lds, 12) + l * 2048, inptr(lds, 13) + l * 512, inptr(lds, 15) + l * 512, inptr(lds, 17) + l * 512, inptr(lds, 18) + l * 512};
#ifndef NO_MIX1
                if (q == 4) mix1_phase(mp, lds, tid);
#endif
#ifndef NO_MIX2
                if (q == 5) mix2_phase(mp, lds, tid);
#endif
            }
        }
        if (ph + 1 < p.ph_hi) {
            if (ph == 0) { grid.sync(); xb = xcd_barrier_post(barw, bst); }
            else xcd_barrier(xb);
        }
    }
}

extern "C" void kernel_launch(void* const* d_in, const int* in_sizes, int n_in, void* d_out, int out_size, void* d_ws, size_t ws_size, hipStream_t stream) {
    static int grid = 0;
    if (grid == 0) {
        if (n_in != 20 || out_size != T * D || ws_size < WS_END) { fprintf(stderr, "kernel_launch: unexpected shapes (n_in %d out %d ws %zu need %zu)\n", n_in, out_size, ws_size, (size_t)WS_END); grid = -1; return; }
        int dev = 0, cus = 0, per_cu = 0;
        hipGetDevice(&dev); hipDeviceGetAttribute(&cus, hipDeviceAttributeMultiprocessorCount, dev);
        if (hipFuncSetAttribute((const void*)mega, hipFuncAttributeMaxDynamicSharedMemorySize, LDS_BYTES) != hipSuccess) { fprintf(stderr, "kernel_launch: hipFuncSetAttribute failed\n"); grid = -1; return; }
        if (hipOccupancyMaxActiveBlocksPerMultiprocessor(&per_cu, (const void*)mega, 512, LDS_BYTES) != hipSuccess || per_cu < 1) { fprintf(stderr, "kernel_launch: occupancy query says %d\n", per_cu); per_cu = 1; }
        (void)hipGetLastError();
        grid = cus * per_cu;
    }
    if (grid < 0) return;
    Params p{};
    for (int i = 0; i < 20; ++i) p.in[i] = (const float*)d_in[i];
    p.out = (float*)d_out; p.ws = (unsigned char*)d_ws; p.ph_lo = 0; p.ph_hi = NPHASE;
    void* args[] = {&p};
    hipError_t e = hipLaunchCooperativeKernel((const void*)mega, dim3(grid), dim3(512), args, LDS_BYTES, stream);
    if (e != hipSuccess) fprintf(stderr, "kernel_launch: cooperative launch failed: %s (grid %d)\n", hipGetErrorString(e), grid);
}
```

```cpp
#include <hip/hip_runtime.h>
#include <hip/hip_cooperative_groups.h>
#include <cstdio>
namespace cg = cooperative_groups;
namespace pg8 {
#define PG8_LAS __attribute__((address_space(3)))
typedef unsigned short bf16_t;
typedef short bf16x8 __attribute__((ext_vector_type(8)));
typedef float f32x4 __attribute__((ext_vector_type(4)));
typedef unsigned u32x4 __attribute__((ext_vector_type(4)));
constexpr int BM = 256, BK = 64, HALF = 128, HTB = HALF * BK * 2  , STAGE_BYTES = 8 * HTB, NXCD = 8, WGM = 8;

__host__ __device__ __forceinline__ int lds_byte(int r, int c) { const int st = (r >> 4) * 2 + (c >> 5), rr = r & 15, cc = c & 31, ob = rr * 64 + cc * 2; return st * 1024 + (ob ^ (((ob >> 9) & 1) << 5)); }
__host__ __device__ __forceinline__ void stage_rc(int b, int& R, int& C) { const int st = b / 1024, sb = b % 1024, swz = sb ^ (((sb >> 9) & 1) << 5); R = (st >> 1) * 16 + swz / 64; C = (st & 1) * 32 + (swz % 64) / 2; }
__host__ __device__ __forceinline__ int perm32(int rho) { const int n = rho >> 4, i = rho & 15; return 8 * (i >> 2) + 4 * n + (i & 3); }

struct Unit { int pm, pn; };
struct Gemm { const bf16_t* A; const bf16_t* Bt; int M, N, K; };

struct StaticOrder {
    int nM, nN, nwg, G, c;
    __host__ __device__ void init(int M, int N, int G_, int c_) { nM = M / BM; nN = N / BM; nwg = nM * nN; G = G_; c = c_; }
    __host__ __device__ bool next(int i, Unit& u) const {
        const long L = (long)i * G + c; if (L >= nwg) return false;
        int wgid = (int)L; { const int q = nwg / NXCD, r = nwg % NXCD, xcd = wgid % NXCD, off = wgid / NXCD; wgid = (xcd < r ? xcd * (q + 1) : r * (q + 1) + (xcd - r) * q) + off; }
        const int nig = WGM * nN, gid = wgid / nig, fm = gid * WGM, gsz = (nM - fm) < WGM ? (nM - fm) : WGM;
        u.pm = fm + ((wgid % nig) % gsz); u.pn = (wgid % nig) / gsz; return true;
    }
    __device__ __forceinline__ void a_ready(const Unit&) const {}
    __device__ __forceinline__ void done(const Unit&) const {}
};
__device__ __forceinline__ unsigned cvt_pk_bf16(float lo, float hi) { unsigned r; asm volatile("v_cvt_pk_bf16_f32 %0, %1, %2" : "=v"(r) : "v"(lo), "v"(hi)); return r; }
template <class Epi, class Sched, bool STAMP = false>
__device__ __forceinline__ void gemm_phase(PG8_LAS unsigned char* lds, const Gemm g, const Sched& S, const Epi& E, unsigned long long* stamps, const int tid) {
    const int wid = __builtin_amdgcn_readfirstlane(tid >> 6), lane = tid & 63, wr = wid >> 2, wc = wid & 3, fr = lane & 15, fq = lane >> 4;
    const int K = g.K, nt = K / BK;
    int ts_lo = 0, ts_hi = 0, nts = 0; const unsigned long long rt_entry = STAMP ? (unsigned long long)wall_clock64() : 0ull;
#define PG8_STAMP() do { if (STAMP && wid == 0 && nts < 64) { const unsigned long long _c = (unsigned long long)clock64(); \
        ts_lo = (lane == nts) ? (int)(unsigned)_c : ts_lo; ts_hi = (lane == nts) ? (int)(unsigned)(_c >> 32) : ts_hi; ++nts; } } while (0)
    PG8_STAMP();
    unsigned voffA[2], voffB[2];
#pragma unroll
    for (int i = 0; i < 2; ++i) { int R, C; stage_rc(tid * 16 + i * 8192, R, C); const int Rb = Epi::PERM ? ((R & ~31) + perm32(R & 31)) : R;
        voffA[i] = (unsigned)(R * K + C) * 2u; voffB[i] = (unsigned)(Rb * K + C) * 2u; }
    const size_t kstep = (size_t)(BK * 2);
    const size_t hstep = (size_t)HALF * K * 2;
    const size_t tstep = 2 * hstep;
    const unsigned ldsw = (unsigned)wid * 1024u;
    const int aoff = lds_byte(wr * 64 + fr, fq * 8), boff = lds_byte(wc * 32 + fr, fq * 8);
#define PG8_SA(b, h) (((b) * 2 + (h)) * HTB)
#define PG8_SB(b, h) ((4 + (b) * 2 + (h)) * HTB)
#define PG8_STAGE(bufoff, gbase, voff) do { _Pragma("unroll") for (int _i = 0; _i < 2; ++_i) \
        __builtin_amdgcn_global_load_lds((const unsigned*)((const char*)(gbase) + (voff)[_i]), (PG8_LAS unsigned*)(lds + (bufoff) + ldsw + _i * 8192), 16, 0, 0); } while (0)
#define PG8_LDA(dst, b, h) do { _Pragma("unroll") for (int m = 0; m < 4; ++m) _Pragma("unroll") for (int k = 0; k < 2; ++k) dst[m][k] = *(const PG8_LAS bf16x8*)(lds + PG8_SA(b, h) + aoff + m * 2048 + k * 1024); } while (0)
#define PG8_LDB(dst, b, h) do { _Pragma("unroll") for (int n = 0; n < 2; ++n) _Pragma("unroll") for (int k = 0; k < 2; ++k) dst[n][k] = *(const PG8_LAS bf16x8*)(lds + PG8_SB(b, h) + boff + n * 2048 + k * 1024); } while (0)
#define PG8_MMA(ai, bj, At, Bt) do { __builtin_amdgcn_s_setprio(1); _Pragma("unroll") for (int m = 0; m < 4; ++m) _Pragma("unroll") for (int n = 0; n < 2; ++n) _Pragma("unroll") for (int k = 0; k < 2; ++k) \
        acc[ai][bj][m][n] = __builtin_amdgcn_mfma_f32_16x16x32_bf16(Bt[n][k], At[m][k], acc[ai][bj][m][n], 0, 0, 0); __builtin_amdgcn_s_setprio(0); } while (0)
#define PG8_WAIT_V(n) asm volatile("s_waitcnt vmcnt(" #n ")" ::: "memory")
#define PG8_WAIT_L(n) asm volatile("s_waitcnt lgkmcnt(" #n ")" ::: "memory")
#define PG8_BAR __builtin_amdgcn_s_barrier()
#define PG8_SCHED __builtin_amdgcn_sched_barrier(0)
    Unit cur, nxt; int ui = 0;
    if (!S.next(0, cur)) return;
    f32x4 acc[2][2][4][2];
#pragma unroll
    for (int a = 0; a < 2; ++a)
#pragma unroll
        for (int b = 0; b < 2; ++b)
#pragma unroll
            for (int m = 0; m < 4; ++m)
#pragma unroll
                for (int n = 0; n < 2; ++n) acc[a][b][m][n] = (f32x4){0.f, 0.f, 0.f, 0.f};
    bf16x8 At[4][2], B0[2][2], B1[2][2];
    const char* cA = (const char*)g.A + (size_t)cur.pm * tstep; const char* cB = (const char*)g.Bt + (size_t)cur.pn * tstep;
    S.a_ready(cur);
    PG8_STAGE(PG8_SB(0, 0), cB, voffB); PG8_STAGE(PG8_SA(0, 0), cA, voffA); PG8_STAGE(PG8_SB(0, 1), cB + hstep, voffB); PG8_STAGE(PG8_SA(0, 1), cA + hstep, voffA);
    if (wr == 1) PG8_BAR;
    PG8_WAIT_V(4); PG8_BAR;
    PG8_STAGE(PG8_SB(1, 0), cB + kstep, voffB); PG8_STAGE(PG8_SA(1, 0), cA + kstep, voffA); PG8_STAGE(PG8_SB(1, 1), cB + hstep + kstep, voffB);
    PG8_WAIT_V(6); PG8_BAR;
    PG8_STAMP();
    for (;;) {
        const bool has_next = S.next(ui + 1, nxt);
        const char* nA = has_next ? (const char*)g.A + (size_t)nxt.pm * tstep : cA; const char* nB = has_next ? (const char*)g.Bt + (size_t)nxt.pn * tstep : cB;
        for (int t = 0; t < nt; t += 2) {
            const bool last = (t == nt - 2);
            const char* a1 = cA + (size_t)(t + 1) * kstep;
            const char* a2 = last ? nA : cA + (size_t)(t + 2) * kstep; const char* b2 = last ? nB : cB + (size_t)(t + 2) * kstep;
            const char* a3 = a2 + kstep; const char* b3 = b2 + kstep;
            if (last && has_next) S.a_ready(nxt);
            PG8_LDB(B0, 0, 0); PG8_SCHED; PG8_LDA(At, 0, 0); PG8_STAGE(PG8_SA(1, 1), a1 + hstep, voffA);
            PG8_WAIT_L(8); PG8_BAR; PG8_WAIT_L(0); PG8_MMA(0, 0, At, B0); PG8_BAR; PG8_SCHED;
            PG8_LDB(B1, 0, 1); PG8_STAGE(PG8_SB(0, 0), b2, voffB);
            PG8_BAR; PG8_WAIT_L(0); PG8_MMA(0, 1, At, B1); PG8_BAR;
            PG8_LDA(At, 0, 1); PG8_STAGE(PG8_SA(0, 0), a2, voffA);
            PG8_BAR; PG8_WAIT_L(0); PG8_MMA(1, 0, At, B0); PG8_BAR; PG8_SCHED;
            PG8_STAGE(PG8_SB(0, 1), b2 + hstep, voffB);
            PG8_WAIT_V(6); PG8_BAR; PG8_MMA(1, 1, At, B1); PG8_BAR;
            PG8_LDB(B0, 1, 0); PG8_SCHED; PG8_LDA(At, 1, 0); PG8_STAGE(PG8_SA(0, 1), a2 + hstep, voffA);
            PG8_WAIT_L(8); PG8_BAR; PG8_WAIT_L(0); PG8_MMA(0, 0, At, B0); PG8_BAR; PG8_SCHED;
            PG8_LDB(B1, 1, 1); PG8_STAGE(PG8_SB(1, 0), b3, voffB);
            PG8_BAR; PG8_WAIT_L(0); PG8_MMA(0, 1, At, B1); PG8_BAR;
            PG8_LDA(At, 1, 1); PG8_STAGE(PG8_SA(1, 0), a3, voffA);
            PG8_BAR; PG8_WAIT_L(0); PG8_MMA(1, 0, At, B0); PG8_BAR; PG8_SCHED;
            PG8_STAGE(PG8_SB(1, 1), b3 + hstep, voffB);
            PG8_WAIT_V(6); PG8_BAR; PG8_MMA(1, 1, At, B1); PG8_BAR;
        }
        PG8_STAMP();
        if constexpr (!Epi::AFTER_DRAIN) { E(acc, cur, wr, wc, fr, fq); S.done(cur); }
        PG8_STAMP();
        if (!has_next) break;
#pragma unroll
        for (int a = 0; a < 2; ++a)
#pragma unroll
            for (int b = 0; b < 2; ++b)
#pragma unroll
                for (int m = 0; m < 4; ++m)
#pragma unroll
                    for (int n = 0; n < 2; ++n) acc[a][b][m][n] = (f32x4){0.f, 0.f, 0.f, 0.f};
        cur = nxt; cA = nA; cB = nB; ++ui;
    }
    PG8_WAIT_V(0);
    if (wr == 0) PG8_BAR;
    PG8_BAR;
    if constexpr (Epi::AFTER_DRAIN) { E.fused(acc, cur, wr, wc, fr, fq, lds, wid, lane); S.done(cur); }
    PG8_STAMP();
    if (STAMP && wid == 0) { stamps[lane] = lane < nts ? (((unsigned long long)(unsigned)ts_hi << 32) | (unsigned)ts_lo) : 0ull;
        if (lane == 62) stamps[62] = rt_entry; if (lane == 63) stamps[63] = (unsigned long long)wall_clock64(); }
#undef PG8_STAMP
#undef PG8_SA
#undef PG8_SB
#undef PG8_STAGE
#undef PG8_LDA
#undef PG8_LDB
#undef PG8_MMA
#undef PG8_WAIT_V
#undef PG8_WAIT_L
#undef PG8_BAR
#undef PG8_SCHED
}
}

using pg8::bf16_t; using pg8::bf16x8; using pg8::f32x4; using pg8::u32x4;
typedef unsigned u32x2 __attribute__((ext_vector_type(2)));
#define LAS __attribute__((address_space(3)))

#define XB_TMO      128
#define XB_XCNT(j)  (256  + 64 * (j))
#define XB_XSUB(j)  (1280 + 64 * (j))
#define XB_XGEN(j)  (2304 + 64 * (j))
#define XB_TOP      3328
#define XB_TOPGEN   3392
#define XCD_BAR_WORDS 3456
#define XB_SPIN_CAP (1u << 18)

__device__ __forceinline__ unsigned xb_ld(unsigned* p)              { return __hip_atomic_load(p, __ATOMIC_RELAXED, __HIP_MEMORY_SCOPE_AGENT); }
__device__ __forceinline__ unsigned xb_add(unsigned* p, unsigned v) { return __hip_atomic_fetch_add(p, v, __ATOMIC_RELAXED, __HIP_MEMORY_SCOPE_AGENT); }
__device__ __forceinline__ unsigned xb_xcc_id() { return (unsigned)__builtin_amdgcn_s_getreg((3 << 11) | 20) & 0xFu; }
#define XB_SPIN(cond, bar) do { unsigned _sp = 0; while (cond) { __builtin_amdgcn_s_sleep(1); \
    if ((++_sp & 255u) == 0u) { if (xb_ld(&(bar)[XB_TMO])) break; if (_sp > XB_SPIN_CAP) { atomicAdd(&(bar)[XB_TMO], 1u); break; } } } } while (0)

struct XcdBarrier {
    unsigned* bar; unsigned x;
    volatile LAS unsigned* st;
};

__device__ __forceinline__ XcdBarrier xcd_barrier_post(unsigned* bar, volatile LAS unsigned* st) {
    XcdBarrier b; b.bar = bar; b.x = xb_xcc_id(); b.st = st;
    if (threadIdx.x == 0) (void)xb_add(&bar[XB_XCNT(b.x)], 1u);
    return b;
}
__device__ __forceinline__ void xcd_barrier_complete(unsigned* bar, unsigned x, unsigned& nloc, unsigned& nx) {
    const unsigned G = gridDim.x * gridDim.y * gridDim.z;
    unsigned sum, cnt, mine, sp = 0u;
    for (;;) {
        sum = 0u; cnt = 0u; mine = 0u;
#pragma unroll
        for (unsigned j = 0; j < 16; ++j) { const unsigned c = xb_ld(&bar[XB_XCNT(j)]); sum += c; cnt += (c > 0u) ? 1u : 0u; mine = (j == x) ? c : mine; }
        if (sum == G) break;
        __builtin_amdgcn_s_sleep(1);
        if ((++sp & 255u) == 0u) { if (xb_ld(&bar[XB_TMO])) break; if (sp > XB_SPIN_CAP) { atomicAdd(&bar[XB_TMO], 1u); break; } }
    }
    nloc = mine > 0u ? mine : 1u; nx = cnt > 0u ? cnt : 1u;
}

__device__ __forceinline__ void xcd_barrier(const XcdBarrier& b) {
    asm volatile("s_waitcnt vmcnt(0)" ::: "memory");
    __syncthreads();
    if (threadIdx.x == 0) {
        unsigned* bar = b.bar;
        __builtin_amdgcn_s_waitcnt(0);
        unsigned nloc = b.st[0], nx = b.st[1];
        if (nloc == 0u) { xcd_barrier_complete(bar, b.x, nloc, nx); b.st[0] = nloc; b.st[1] = nx; }
        const unsigned old = xb_add(&bar[XB_XSUB(b.x)], 1u);
        const unsigned gen = old / nloc;
        if (old + 1u == (gen + 1u) * nloc) {
            __builtin_amdgcn_fence(__ATOMIC_RELEASE, "agent");
            asm volatile("s_waitcnt vmcnt(0)" ::: "memory");
            const unsigned og = xb_add(&bar[XB_TOP], 1u);
            const unsigned tg = og / nx;
            if (og + 1u == (tg + 1u) * nx) xb_add(&bar[XB_TOPGEN], 1u);
            else XB_SPIN(xb_ld(&bar[XB_TOPGEN]) == tg, bar);
            __builtin_amdgcn_fence(__ATOMIC_ACQUIRE, "agent");
            xb_add(&bar[XB_XGEN(b.x)], 1u);
            asm volatile("s_waitcnt vmcnt(0)" ::: "memory");
        } else {
            XB_SPIN(xb_ld(&bar[XB_XGEN(b.x)]) == gen, bar);
            __builtin_amdgcn_fence(__ATOMIC_ACQUIRE, "agent");
            asm volatile("s_waitcnt vmcnt(0)" ::: "memory");
        }
    }
    __syncthreads();
}


constexpr int T = 32768, D = 1024, FF = 2816, NGU = 5632, NIN = 2304;
constexpr float ALPHA = 1.4142135623730951f;
constexpr float LN_EPS = 1e-5f;
constexpr int LDS_BYTES = 160 * 1024;
constexpr int NPHASE = 23;
constexpr int LDS_PTAB = 159744;

constexpr size_t SZ_WGU = (size_t)NGU * D * 2, SZ_WD = (size_t)D * FF * 2, SZ_WIN = (size_t)NIN * D * 2, SZ_WOUT = (size_t)D * D * 2;
constexpr size_t SZ_SGUW = 4 * 128 * 128 * 2, SZ_RGW = 2 * 8 * 64 * 64 * 2;
constexpr size_t WS_AGG = 0;
constexpr size_t WS_WGU = 1u << 20;
constexpr size_t WS_WD = WS_WGU + 4 * SZ_WGU;
constexpr size_t WS_WIN = WS_WD + 4 * SZ_WD;
constexpr size_t WS_WOUT = WS_WIN + 2 * SZ_WIN;
constexpr size_t WS_SGUW = WS_WOUT + 2 * SZ_WOUT;
constexpr size_t WS_RGW = WS_SGUW + 2 * SZ_SGUW;
constexpr size_t WS_XB = WS_RGW + 2 * SZ_RGW;
constexpr size_t WS_HZ = WS_XB + (size_t)T * D * 2;
constexpr size_t WS_Y = WS_HZ + (size_t)T * FF * 2;
constexpr size_t WS_BAR = WS_Y + (size_t)T * D * 2;
constexpr size_t WS_ST = WS_BAR + 16384;
constexpr size_t WS_END = WS_ST + 6 * (size_t)T * 2 * 4;

struct Params { const float* in[20]; float* out; unsigned char* ws; int ph_lo, ph_hi; };


__device__ __forceinline__ const float* inptr(LAS unsigned char* lds, int i) {
    const u32x2 v = *(LAS const u32x2*)(lds + LDS_PTAB + 8 * i);
    const unsigned long long a = ((unsigned long long)(unsigned)__builtin_amdgcn_readfirstlane((int)v.y) << 32) | (unsigned)__builtin_amdgcn_readfirstlane((int)v.x);
    return (const float*)a;
}

__device__ __forceinline__ float sigmoid_f(float x) { return __builtin_amdgcn_rcpf(1.0f + __builtin_amdgcn_exp2f(-1.4426950408889634f * x)); }
__device__ __forceinline__ float gelu_f(float x) { return x * sigmoid_f(1.5957691216057308f * x * (1.0f + 0.044715f * x * x)); }
__device__ __forceinline__ float bf_lo(unsigned w) { return __uint_as_float(w << 16); }
__device__ __forceinline__ float bf_hi(unsigned w) { return __uint_as_float(w & 0xffff0000u); }
__device__ __forceinline__ unsigned pk_bf16(float lo, float hi) { return pg8::cvt_pk_bf16(lo, hi); }
__device__ __forceinline__ float wave_sum(float v) {
    v += __builtin_bit_cast(float, __builtin_amdgcn_update_dpp(0, __builtin_bit_cast(int, v), 0xB1, 0xF, 0xF, true));
    v += __builtin_bit_cast(float, __builtin_amdgcn_update_dpp(0, __builtin_bit_cast(int, v), 0x4E, 0xF, 0xF, true));
    v += __builtin_bit_cast(float, __builtin_amdgcn_update_dpp(0, __builtin_bit_cast(int, v), 0x141, 0xF, 0xF, true));
    v += __builtin_bit_cast(float, __builtin_amdgcn_update_dpp(0, __builtin_bit_cast(int, v), 0x140, 0xF, 0xF, true));
    v += __shfl_xor(v, 16); v += __shfl_xor(v, 32);
    return v;
}

struct EpiSwiGLU {
    static constexpr bool PERM = true, AFTER_DRAIN = false;
    bf16_t* O;
    __device__ __forceinline__ void operator()(const f32x4 (&acc)[2][2][4][2], const pg8::Unit& u, int wr, int wc, int fr, int fq) const {
        const int row0 = u.pm * 256 + wr * 64 + fr, col0 = u.pn * 128 + wc * 32 + 8 * fq;
#pragma unroll
        for (int ai = 0; ai < 2; ++ai)
#pragma unroll
            for (int m = 0; m < 4; ++m) {
                bf16_t* rowp = O + (size_t)(row0 + ai * 128 + m * 16) * FF + col0;
                const f32x4 g0 = acc[ai][0][m][0], g1 = acc[ai][0][m][1], u0 = acc[ai][1][m][0], u1 = acc[ai][1][m][1];
                float h[8];
#pragma unroll
                for (int j = 0; j < 4; ++j) { h[j] = g0[j] * sigmoid_f(g0[j]) * u0[j]; h[4 + j] = g1[j] * sigmoid_f(g1[j]) * u1[j]; }
                u32x4 w; w.x = pk_bf16(h[0], h[1]); w.y = pk_bf16(h[2], h[3]); w.z = pk_bf16(h[4], h[5]); w.w = pk_bf16(h[6], h[7]);
                *(u32x4*)rowp = w;
            }
    }
};
typedef float f32x2 __attribute__((ext_vector_type(2)));
struct EpiRes {
    static constexpr bool PERM = true, AFTER_DRAIN = false;
    const float* res; float* out; float scale; const float* St; const float* gp; const float* bp;
    __device__ __forceinline__ void operator()(const f32x4 (&acc)[2][2][4][2], const pg8::Unit& u, int wr, int wc, int fr, int fq) const {
        const int row0 = u.pm * 256 + wr * 64 + fr, col0 = u.pn * 256 + wc * 32 + 8 * fq;
        const bool has = St != nullptr; const float* st2 = has ? St : res; const float* g2 = has ? gp : res; const float* b2 = has ? bp : res;
        f32x4 gv[2][2], bv[2][2];
#pragma unroll
        for (int bj = 0; bj < 2; ++bj)
#pragma unroll
            for (int n = 0; n < 2; ++n) { gv[bj][n] = *(const f32x4*)(g2 + col0 + bj * 128 + n * 4); bv[bj][n] = *(const f32x4*)(b2 + col0 + bj * 128 + n * 4); }
        if (!has) {
#pragma unroll
            for (int bj = 0; bj < 2; ++bj)
#pragma unroll
                for (int n = 0; n < 2; ++n) { gv[bj][n] = (f32x4){1.f, 1.f, 1.f, 1.f}; bv[bj][n] = (f32x4){0.f, 0.f, 0.f, 0.f}; }
        }
#pragma unroll
        for (int ai = 0; ai < 2; ++ai)
#pragma unroll
            for (int mp = 0; mp < 2; ++mp) {
                f32x4 r[2][2][2]; f32x2 st[2];
#pragma unroll
                for (int e = 0; e < 2; ++e) { const int row = row0 + ai * 128 + (2 * mp + e) * 16; const size_t off = (size_t)row * D + col0;
                    st[e] = *(const f32x2*)(st2 + 2 * (size_t)row);
#pragma unroll
                    for (int bj = 0; bj < 2; ++bj)
#pragma unroll
                        for (int n = 0; n < 2; ++n) r[e][bj][n] = *(const f32x4*)(res + off + bj * 128 + n * 4); }
#pragma unroll
                for (int e = 0; e < 2; ++e) { const int m = 2 * mp + e; const int row = row0 + ai * 128 + m * 16; const size_t off = (size_t)row * D + col0;
                    if (!has) st[e] = (f32x2){0.f, 1.f};
#pragma unroll
                    for (int bj = 0; bj < 2; ++bj)
#pragma unroll
                        for (int n = 0; n < 2; ++n) { const f32x4 xh = (r[e][bj][n] - st[e].x) * st[e].y * gv[bj][n] + bv[bj][n];
                            *(f32x4*)(out + off + bj * 128 + n * 4) = ALPHA * xh + scale * acc[ai][bj][m][n]; } }
                asm volatile("" ::: "memory");
            }
    }
};
struct EpiBf16 {
    static constexpr bool PERM = true, AFTER_DRAIN = false;
    bf16_t* O; int ldc;
    __device__ __forceinline__ void operator()(const f32x4 (&acc)[2][2][4][2], const pg8::Unit& u, int wr, int wc, int fr, int fq) const {
        const int row0 = u.pm * 256 + wr * 64 + fr, col0 = u.pn * 256 + wc * 32 + 8 * fq;
#pragma unroll
        for (int ai = 0; ai < 2; ++ai)
#pragma unroll
            for (int m = 0; m < 4; ++m) {
                bf16_t* rowp = O + (size_t)(row0 + ai * 128 + m * 16) * ldc + col0;
#pragma unroll
                for (int bj = 0; bj < 2; ++bj) { const f32x4 v0 = acc[ai][bj][m][0], v1 = acc[ai][bj][m][1];
                    u32x4 w; w.x = pk_bf16(v0[0], v0[1]); w.y = pk_bf16(v0[2], v0[3]); w.z = pk_bf16(v1[0], v1[1]); w.w = pk_bf16(v1[2], v1[3]);
                    *(u32x4*)(rowp + bj * 128) = w; }
            }
    }
};


struct EpiAny {
    static constexpr bool PERM = true, AFTER_DRAIN = false;
    int mode; bf16_t* O; int ldc; const float* res; float* out; float scale; const float* St; const float* gp; const float* bp;
    __device__ __forceinline__ void operator()(const f32x4 (&acc)[2][2][4][2], const pg8::Unit& u, int wr, int wc, int fr, int fq) const {
        if (mode == 0) { EpiSwiGLU e{O}; e(acc, u, wr, wc, fr, fq); }
        else if (mode == 1) { EpiRes e{res, out, scale, St, gp, bp}; e(acc, u, wr, wc, fr, fq); }
        else { EpiBf16 e{O, ldc}; e(acc, u, wr, wc, fr, fq); }
    }
};

__device__ __forceinline__ void prologue_phase(unsigned char* ws, LAS unsigned char* lds, const int tid) {
    LAS float* tile = (LAS float*)lds;
    for (int jb = blockIdx.x * 4; jb < 10112; jb += gridDim.x * 4) {
        float lv[4][8];
#pragma unroll
        for (int u = 0; u < 4; ++u) {
            const int j = jb + u; const float* src; int N, t;
            if (j < 5632) { const int m = j / 704; t = j % 704; N = FF; src = inptr(lds, (m & 1) ? 4 : 3) + (size_t)(m >> 1) * D * FF; }
            else if (j < 8448) { const int j2 = j - 5632; t = j2 % 704; N = D; src = inptr(lds, 5) + (size_t)(j2 / 704) * FF * D; }
            else if (j < 9600) { const int j3 = j - 8448; t = j3 % 576; N = NIN; src = inptr(lds, 6) + (size_t)(j3 / 576) * D * NIN; }
            else { const int j4 = j - 9600; t = j4 % 256; N = D; src = inptr(lds, 19) + (size_t)(j4 / 256) * D * D; }
            const int ntn = N / 64, k0 = (t / ntn) * 64, n0 = (t % ntn) * 64;
#pragma unroll
            for (int it = 0; it < 8; ++it) lv[u][it] = src[(size_t)(k0 + it * 8 + (tid >> 6)) * N + n0 + (tid & 63)];
        }
#pragma unroll
        for (int u = 0; u < 4; ++u)
#pragma unroll
            for (int it = 0; it < 8; ++it) tile[u * 4160 + (it * 8 + (tid >> 6)) * 65 + (tid & 63)] = lv[u][it];
        __syncthreads();
#pragma unroll
        for (int u = 0; u < 4; ++u) {
            const int j = jb + u; bf16_t* dst; int K, N, which = -1, t;
            if (j < 5632) { const int m = j / 704; t = j % 704; which = m & 1; K = D; N = FF; dst = (bf16_t*)(ws + WS_WGU + (size_t)(m >> 1) * SZ_WGU); }
            else if (j < 8448) { const int j2 = j - 5632; t = j2 % 704; K = FF; N = D; dst = (bf16_t*)(ws + WS_WD + (size_t)(j2 / 704) * SZ_WD); }
            else if (j < 9600) { const int j3 = j - 8448; t = j3 % 576; K = D; N = NIN; dst = (bf16_t*)(ws + WS_WIN + (size_t)(j3 / 576) * SZ_WIN); }
            else { const int j4 = j - 9600; t = j4 % 256; K = D; N = D; dst = (bf16_t*)(ws + WS_WOUT + (size_t)(j4 / 256) * SZ_WOUT); }
            const int ntn = N / 64, k0 = (t / ntn) * 64, n0 = (t % ntn) * 64;
            const int kp = tid & 31, jq = tid >> 5;
#pragma unroll
            for (int it = 0; it < 4; ++it) { const int jj = it * 16 + jq, n = n0 + jj; const int rho = which < 0 ? n : (256 * (n >> 7) + 128 * which + (n & 127));
                *(unsigned*)(dst + (size_t)rho * K + k0 + 2 * kp) = pk_bf16(tile[u * 4160 + (2 * kp) * 65 + jj], tile[u * 4160 + (2 * kp + 1) * 65 + jj]); }
        }
        __syncthreads();
    }
    const size_t gtid = (size_t)blockIdx.x * 512 + tid, gsz = (size_t)gridDim.x * 512;
    { const float* x = inptr(lds, 0); bf16_t* xb = (bf16_t*)(ws + WS_XB);
      for (size_t v = gtid; v < (size_t)T * D / 8; v += gsz) { const f32x4 a = *(const f32x4*)(x + v * 8), b = *(const f32x4*)(x + v * 8 + 4);
          u32x4 w; w.x = pk_bf16(a[0], a[1]); w.y = pk_bf16(a[2], a[3]); w.z = pk_bf16(b[0], b[1]); w.w = pk_bf16(b[2], b[3]); *(u32x4*)(xb + v * 8) = w; } }
    for (size_t i = gtid; i < 2 * 4 * 128 * 128; i += gsz) { const int s = (int)(i & 127), tt = (int)((i >> 7) & 127); const float v = s <= tt ? inptr(lds, 9)[i] : 0.f;
        ((bf16_t*)(ws + WS_SGUW))[i] = (bf16_t)(pk_bf16(v, 0.f) & 0xffffu); }
    for (size_t i = gtid; i < 2 * 2 * 8 * 64 * 64; i += gsz) { const int d = (int)(i & 63), e = (int)((i >> 6) & 63), h = (int)((i >> 12) & 7), g = (int)((i >> 15) & 1), l = (int)(i >> 16);
        const float v = inptr(lds, g ? 16 : 14)[(((size_t)l * 8 + h) * 64 + d) * 64 + e];
        ((bf16_t*)(ws + WS_RGW))[i] = (bf16_t)(pk_bf16(v, 0.f) & 0xffffu); }
}

__device__ __forceinline__ void ln_phase(float* X, bf16_t* XB, float* St, const bool fin, const float* g, const float* b, const int tid) {
    const int lane = tid & 63, wid = tid >> 6;
    f32x4 gv[4], bv[4];
#pragma unroll
    for (int i = 0; i < 4; ++i) { gv[i] = *(const f32x4*)(g + 4 * lane + 256 * i); bv[i] = *(const f32x4*)(b + 4 * lane + 256 * i); }
    for (int r0 = (blockIdx.x * 8 + wid) * 4; r0 < T; r0 += gridDim.x * 32) {
        f32x4 v[4][4];
#pragma unroll
        for (int rr = 0; rr < 4; ++rr)
#pragma unroll
            for (int i = 0; i < 4; ++i) v[rr][i] = *(const f32x4*)(X + (size_t)(r0 + rr) * D + 4 * lane + 256 * i);
        float s[4], q[4];
#pragma unroll
        for (int rr = 0; rr < 4; ++rr) { s[rr] = 0.f;
#pragma unroll
            for (int i = 0; i < 4; ++i) s[rr] += (v[rr][i][0] + v[rr][i][1]) + (v[rr][i][2] + v[rr][i][3]); }
#pragma unroll
        for (int o = 32; o >= 1; o >>= 1)
#pragma unroll
            for (int rr = 0; rr < 4; ++rr) s[rr] += __shfl_xor(s[rr], o);
#pragma unroll
        for (int rr = 0; rr < 4; ++rr) { const float mean = s[rr] * (1.0f / D); q[rr] = 0.f;
#pragma unroll
            for (int i = 0; i < 4; ++i) { v[rr][i] -= mean; q[rr] += (v[rr][i][0] * v[rr][i][0] + v[rr][i][1] * v[rr][i][1]) + (v[rr][i][2] * v[rr][i][2] + v[rr][i][3] * v[rr][i][3]); } }
#pragma unroll
        for (int o = 32; o >= 1; o >>= 1)
#pragma unroll
            for (int rr = 0; rr < 4; ++rr) q[rr] += __shfl_xor(q[rr], o);
#pragma unroll
        for (int rr = 0; rr < 4; ++rr) { const float rstd = rsqrtf(q[rr] * (1.0f / D) + LN_EPS);
            float* xr = X + (size_t)(r0 + rr) * D + 4 * lane; bf16_t* xbr = XB + (size_t)(r0 + rr) * D + 4 * lane;
            if (!fin && lane == 0) *(f32x2*)(St + 2 * (size_t)(r0 + rr)) = (f32x2){s[rr] * (1.0f / D), rstd};
#pragma unroll
            for (int i = 0; i < 4; ++i) { const f32x4 y = v[rr][i] * rstd * gv[i] + bv[i];
                if (fin) *(f32x4*)(xr + 256 * i) = y;
                else { u32x2 w; w.x = pk_bf16(y[0], y[1]); w.y = pk_bf16(y[2], y[3]); *(u32x2*)(xbr + 256 * i) = w; } } }
    }
}

struct MixP { const bf16_t* Z; bf16_t* Y; float* agg; const bf16_t* sguw; const bf16_t* rgw;
    const float *sgu_ln_g, *sgu_ln_b, *sgu_b, *sconv_w, *rg_conv_w, *rg_conv_b, *rg_b_a, *rg_b_i, *rg_lambda; };
constexpr int VT_PITCH = 136;
constexpr int LDS_VT = 0;
constexpr int LDS_RG = 69632;
constexpr int LDS_CONST = 139264;

__device__ __forceinline__ void mix_consts(const MixP& mp, LAS unsigned char* lds, const int tid) {
    LAS float* CW = (LAS float*)(lds + LDS_CONST);
    for (int i = tid; i < 2048; i += 512) CW[i] = mp.rg_conv_w[i];
    CW[2048 + tid] = mp.rg_conv_b[tid]; CW[2560 + tid] = mp.rg_b_a[tid]; CW[3072 + tid] = mp.rg_b_i[tid];
    CW[3584 + tid] = 8.0f * log1pf(expf(-mp.rg_lambda[tid]));
    __syncthreads();
}

template <bool FULL>
__device__ __forceinline__ void rg_tile(const MixP& mp, int tile, LAS unsigned char* lds, int wid, int lane, float carry) {
    const int fr = lane & 15, fq = lane >> 4, h = wid;
    const int t0 = tile * 128, seq0 = (tile >> 7) << 14;
    LAS float* P0 = (LAS float*)(lds + LDS_RG + wid * 8704); LAS float* P1 = P0 + 16 * 68;
    LAS const float* CW = (LAS const float*)(lds + LDS_CONST);
    bf16x8 wf[2][2][4];
#pragma unroll
    for (int g = 0; g < 2; ++g)
#pragma unroll
        for (int ks = 0; ks < 2; ++ks)
#pragma unroll
            for (int n = 0; n < 4; ++n) wf[g][ks][n] = *(const bf16x8*)(mp.rgw + ((size_t)((g * 8 + h) * 64 + 16 * n + fr) * 64 + 32 * ks + 8 * fq));
    float hst = carry, ap = 1.0f;
    const bf16_t* zx = mp.Z + 1792 + 64 * h + 8 * fq;
    const int cbase = 64 * h + 8 * fq;
    u32x4 own_prev[2], own_cur[2], own_next[2];
    { const int tp = t0 - 16 + fr; const bool ok = tp >= seq0;
#pragma unroll
      for (int ks = 0; ks < 2; ++ks) { own_prev[ks] = ok ? *(const u32x4*)(zx + (size_t)tp * NIN + 32 * ks) : (u32x4){0u, 0u, 0u, 0u}; own_cur[ks] = *(const u32x4*)(zx + (size_t)(t0 + fr) * NIN + 32 * ks); own_next[ks] = own_cur[ks]; } }
    for (int g = 0; g < 8; ++g) {
        if (g < 7) {
#pragma unroll
            for (int ks = 0; ks < 2; ++ks) own_next[ks] = *(const u32x4*)(zx + (size_t)(t0 + 16 * (g + 1) + fr) * NIN + 32 * ks);
        }
        bf16x8 xa[2];
#pragma unroll
        for (int ks = 0; ks < 2; ++ks) {
            f32x4 c0 = *(LAS const f32x4*)(CW + 2048 + cbase + 32 * ks), c1 = *(LAS const f32x4*)(CW + 2048 + cbase + 32 * ks + 4);
#pragma unroll
            for (int k = 0; k < 4; ++k) { const f32x4 w0 = *(LAS const f32x4*)(CW + k * 512 + cbase + 32 * ks), w1 = *(LAS const f32x4*)(CW + k * 512 + cbase + 32 * ks + 4);
                u32x4 x;
                if (k == 3) x = own_cur[ks];
                else {
#define ROR(v, K) (unsigned)__builtin_amdgcn_update_dpp(0, (int)(v), 0x120 + (K), 0xF, 0xF, false)
                    const u32x4 c = own_cur[ks], p = own_prev[ks]; u32x4 rc, rp;
                    if (k == 2) { rc.x = ROR(c.x, 1); rc.y = ROR(c.y, 1); rc.z = ROR(c.z, 1); rc.w = ROR(c.w, 1); rp.x = ROR(p.x, 1); rp.y = ROR(p.y, 1); rp.z = ROR(p.z, 1); rp.w = ROR(p.w, 1); }
                    else if (k == 1) { rc.x = ROR(c.x, 2); rc.y = ROR(c.y, 2); rc.z = ROR(c.z, 2); rc.w = ROR(c.w, 2); rp.x = ROR(p.x, 2); rp.y = ROR(p.y, 2); rp.z = ROR(p.z, 2); rp.w = ROR(p.w, 2); }
                    else { rc.x = ROR(c.x, 3); rc.y = ROR(c.y, 3); rc.z = ROR(c.z, 3); rc.w = ROR(c.w, 3); rp.x = ROR(p.x, 3); rp.y = ROR(p.y, 3); rp.z = ROR(p.z, 3); rp.w = ROR(p.w, 3); }
#undef ROR
                    const bool cur = fr >= 3 - k;
                    x.x = cur ? rc.x : rp.x; x.y = cur ? rc.y : rp.y; x.z = cur ? rc.z : rp.z; x.w = cur ? rc.w : rp.w;
                }
                c0[0] += w0[0] * bf_lo(x.x); c0[1] += w0[1] * bf_hi(x.x); c0[2] += w0[2] * bf_lo(x.y); c0[3] += w0[3] * bf_hi(x.y);
                c1[0] += w1[0] * bf_lo(x.z); c1[1] += w1[1] * bf_hi(x.z); c1[2] += w1[2] * bf_lo(x.w); c1[3] += w1[3] * bf_hi(x.w); }
            *(LAS f32x4*)(P0 + fr * 68 + 32 * ks + 8 * fq) = c0; *(LAS f32x4*)(P0 + fr * 68 + 32 * ks + 8 * fq + 4) = c1;
            u32x4 pk; pk.x = pk_bf16(c0[0], c0[1]); pk.y = pk_bf16(c0[2], c0[3]); pk.z = pk_bf16(c1[0], c1[1]); pk.w = pk_bf16(c1[2], c1[3]);
            xa[ks] = __builtin_bit_cast(bf16x8, pk);
        }
#pragma unroll
        for (int ks = 0; ks < 2; ++ks) { own_prev[ks] = own_cur[ks]; own_cur[ks] = own_next[ks]; }
        f32x4 ar[4], ai[4];
#pragma unroll
        for (int n = 0; n < 4; ++n) { ar[n] = (f32x4){0.f, 0.f, 0.f, 0.f}; ai[n] = (f32x4){0.f, 0.f, 0.f, 0.f};
#pragma unroll
            for (int ks = 0; ks < 2; ++ks) { ar[n] = __builtin_amdgcn_mfma_f32_16x16x32_bf16(wf[0][ks][n], xa[ks], ar[n], 0, 0, 0); ai[n] = __builtin_amdgcn_mfma_f32_16x16x32_bf16(wf[1][ks][n], xa[ks], ai[n], 0, 0, 0); } }
        asm volatile("s_waitcnt lgkmcnt(0)" ::: "memory");
        f32x4 av[4], bv[4];
#pragma unroll
        for (int n = 0; n < 4; ++n) { const int e = 64 * h + 16 * n + 4 * fq;
            const f32x4 ba = *(LAS const f32x4*)(CW + 2560 + e), bi = *(LAS const f32x4*)(CW + 3072 + e), sp = *(LAS const f32x4*)(CW + 3584 + e), xc = *(LAS const f32x4*)(P0 + fr * 68 + 16 * n + 4 * fq);
#pragma unroll
            for (int j = 0; j < 4; ++j) { const float r = sigmoid_f(ar[n][j] + ba[j]), ig = sigmoid_f(ai[n][j] + bi[j]);
                const float a = __builtin_amdgcn_exp2f(-1.4426950408889634f * r * sp[j]); const float m2 = fmaxf(1.0f - a * a, 0.0f);
                av[n][j] = a; bv[n][j] = __builtin_amdgcn_sqrtf(m2) * (ig * xc[j]); } }
        asm volatile("s_waitcnt lgkmcnt(0)" ::: "memory");
#pragma unroll
        for (int n = 0; n < 4; ++n) { *(LAS f32x4*)(P0 + fr * 68 + 16 * n + 4 * fq) = av[n]; *(LAS f32x4*)(P1 + fr * 68 + 16 * n + 4 * fq) = bv[n]; }
        asm volatile("s_waitcnt lgkmcnt(0)" ::: "memory");
#pragma unroll
        for (int t = 0; t < 16; ++t) { const float a = P0[t * 68 + lane], b = P1[t * 68 + lane]; hst = a * hst + b; if (!FULL) ap *= a; if (FULL) P1[t * 68 + lane] = hst; }
        if (FULL) {
            asm volatile("s_waitcnt lgkmcnt(0)" ::: "memory");
#pragma unroll
            for (int it = 0; it < 2; ++it) { const int tkn = it * 8 + (lane >> 3), c8 = (lane & 7) * 8; const size_t tg = (size_t)(t0 + 16 * g + tkn);
                const f32x4 h0 = *(LAS const f32x4*)(P1 + tkn * 68 + c8), h1 = *(LAS const f32x4*)(P1 + tkn * 68 + c8 + 4);
                const u32x4 gt = *(const u32x4*)(mp.Z + tg * NIN + 1280 + 64 * h + c8);
                u32x4 w; w.x = pk_bf16(gelu_f(bf_lo(gt.x)) * h0[0], gelu_f(bf_hi(gt.x)) * h0[1]); w.y = pk_bf16(gelu_f(bf_lo(gt.y)) * h0[2], gelu_f(bf_hi(gt.y)) * h0[3]);
                w.z = pk_bf16(gelu_f(bf_lo(gt.z)) * h1[0], gelu_f(bf_hi(gt.z)) * h1[1]); w.w = pk_bf16(gelu_f(bf_lo(gt.w)) * h1[2], gelu_f(bf_hi(gt.w)) * h1[3]);
                *(u32x4*)(mp.Y + tg * D + 512 + 64 * h + c8) = w; }
            asm volatile("s_waitcnt lgkmcnt(0)" ::: "memory");
        }
    }
    if (!FULL) { mp.agg[(size_t)tile * 1024 + 64 * h + lane] = ap; mp.agg[(size_t)tile * 1024 + 512 + 64 * h + lane] = hst; }
}

__device__ __forceinline__ void mix1_phase(const MixP& mp, LAS unsigned char* lds, const int tid) {
    const int lane = tid & 63, wid = __builtin_amdgcn_readfirstlane(tid >> 6);
    mix_consts(mp, lds, tid);
    for (int tile = blockIdx.x; tile < 256; tile += gridDim.x) rg_tile<false>(mp, tile, lds, wid, lane, 0.0f);
}

__device__ __forceinline__ void mix2_phase(const MixP& mp, LAS unsigned char* lds, const int tid) {
    const int lane = tid & 63, wid = __builtin_amdgcn_readfirstlane(tid >> 6), fr = lane & 15, fq = lane >> 4;
    mix_consts(mp, lds, tid);
    LAS bf16_t* VT = (LAS bf16_t*)(lds + LDS_VT);
    for (int tile = blockIdx.x; tile < 256; tile += gridDim.x) {
        const int t0 = tile * 128, seq0 = (tile >> 7) << 14;
        {
            const f32x4 gch = *(const f32x4*)(mp.sgu_ln_g + 4 * lane), bch = *(const f32x4*)(mp.sgu_ln_b + 4 * lane);
            u32x2 raw[16];
#pragma unroll
            for (int i = 0; i < 16; ++i) raw[i] = *(const u32x2*)(mp.Z + (size_t)(t0 + 16 * wid + i) * NIN + 256 + 4 * lane);
            unsigned wv[4][8];
#pragma unroll
            for (int i2 = 0; i2 < 8; ++i2) {
                f32x4 vn[2];
#pragma unroll
                for (int e = 0; e < 2; ++e) { const u32x2 rw = raw[2 * i2 + e];
                    f32x4 v = {gelu_f(bf_lo(rw.x)), gelu_f(bf_hi(rw.x)), gelu_f(bf_lo(rw.y)), gelu_f(bf_hi(rw.y))};
                    const float mean = wave_sum((v[0] + v[1]) + (v[2] + v[3])) * (1.0f / 256.0f);
                    v -= mean;
                    const float rstd = rsqrtf(wave_sum((v[0] * v[0] + v[1] * v[1]) + (v[2] * v[2] + v[3] * v[3])) * (1.0f / 256.0f) + LN_EPS);
                    vn[e] = v * rstd * gch + bch; }
#pragma unroll
                for (int q = 0; q < 4; ++q) wv[q][i2] = pk_bf16(vn[0][q], vn[1][q]);
            }
#pragma unroll
            for (int q = 0; q < 4; ++q)
#pragma unroll
                for (int hf = 0; hf < 2; ++hf) { u32x4 w; w.x = wv[q][4 * hf]; w.y = wv[q][4 * hf + 1]; w.z = wv[q][4 * hf + 2]; w.w = wv[q][4 * hf + 3];
                    *(LAS u32x4*)(VT + (4 * lane + q) * VT_PITCH + 16 * wid + 8 * hf) = w; }
        }
        __syncthreads();
        {
            const int hd = wid >> 1, th = wid & 1;
            bf16x8 vf[4][4];
#pragma unroll
            for (int n = 0; n < 4; ++n)
#pragma unroll
                for (int ks = 0; ks < 4; ++ks) vf[n][ks] = *(LAS const bf16x8*)(VT + (64 * hd + 16 * n + fr) * VT_PITCH + 32 * ks + 8 * fq);
#pragma unroll
            for (int m = 0; m < 4; ++m) {
                const int trow = 64 * th + 16 * m + fr;
                bf16x8 wfr[4];
#pragma unroll
                for (int ks = 0; ks < 4; ++ks) wfr[ks] = *(const bf16x8*)(mp.sguw + ((size_t)(hd * 128 + trow) * 128 + 32 * ks + 8 * fq));
                f32x4 acc[4];
#pragma unroll
                for (int n = 0; n < 4; ++n) { acc[n] = (f32x4){0.f, 0.f, 0.f, 0.f};
#pragma unroll
                    for (int ks = 0; ks < 4; ++ks) acc[n] = __builtin_amdgcn_mfma_f32_16x16x32_bf16(vf[n][ks], wfr[ks], acc[n], 0, 0, 0); }
                const float bs = mp.sgu_b[hd * 128 + trow];
                const size_t tg = (size_t)(t0 + trow);
#pragma unroll
                for (int n = 0; n < 4; ++n) { const int c = 64 * hd + 16 * n + 4 * fq; const u32x2 uu = *(const u32x2*)(mp.Z + tg * NIN + c);
                    u32x2 w; w.x = pk_bf16(gelu_f(bf_lo(uu.x)) * (acc[n][0] + bs), gelu_f(bf_hi(uu.x)) * (acc[n][1] + bs));
                    w.y = pk_bf16(gelu_f(bf_lo(uu.y)) * (acc[n][2] + bs), gelu_f(bf_hi(uu.y)) * (acc[n][3] + bs));
                    *(u32x2*)(mp.Y + tg * D + c) = w; }
            }
        }
#pragma unroll 2
        for (int it = 0; it < 8; ++it) {
            const int item = tid + 512 * it, tkl = item >> 5, c8 = (item & 31) * 8, tok = t0 + tkl;
            const u32x4 bg = *(const u32x4*)(mp.Z + (size_t)tok * NIN + 512 + c8);
            float acc[8];
#pragma unroll
            for (int i = 0; i < 8; ++i) acc[i] = 0.f;
#pragma unroll
            for (int k = 0; k < 3; ++k) { const int tk = tok - 2 + k;
                if (tk >= seq0) { const u32x4 cgv = *(const u32x4*)(mp.Z + (size_t)tk * NIN + 768 + c8), xi = *(const u32x4*)(mp.Z + (size_t)tk * NIN + 1024 + c8);
                    const f32x4 w0 = *(const f32x4*)(mp.sconv_w + k * 256 + c8), w1 = *(const f32x4*)(mp.sconv_w + k * 256 + c8 + 4);
                    acc[0] += w0[0] * (bf_lo(cgv.x) * bf_lo(xi.x)); acc[1] += w0[1] * (bf_hi(cgv.x) * bf_hi(xi.x)); acc[2] += w0[2] * (bf_lo(cgv.y) * bf_lo(xi.y)); acc[3] += w0[3] * (bf_hi(cgv.y) * bf_hi(xi.y));
                    acc[4] += w1[0] * (bf_lo(cgv.z) * bf_lo(xi.z)); acc[5] += w1[1] * (bf_hi(cgv.z) * bf_hi(xi.z)); acc[6] += w1[2] * (bf_lo(cgv.w) * bf_lo(xi.w)); acc[7] += w1[3] * (bf_hi(cgv.w) * bf_hi(xi.w)); } }
            u32x4 w; w.x = pk_bf16(bf_lo(bg.x) * acc[0], bf_hi(bg.x) * acc[1]); w.y = pk_bf16(bf_lo(bg.y) * acc[2], bf_hi(bg.y) * acc[3]);
            w.z = pk_bf16(bf_lo(bg.z) * acc[4], bf_hi(bg.z) * acc[5]); w.w = pk_bf16(bf_lo(bg.w) * acc[6], bf_hi(bg.w) * acc[7]);
            *(u32x4*)(mp.Y + (size_t)tok * D + 256 + c8) = w;
        }
        {
            const int pt = tile & 127, tb = tile - pt, ch = 64 * wid + lane; float c = 0.f;
            const float* ag = mp.agg + (size_t)tb * 1024 + ch; int q = 0;
            for (; q + 32 <= pt; q += 32) { float av[32], hv[32];
#pragma unroll
                for (int i = 0; i < 32; ++i) { av[i] = ag[(size_t)(q + i) * 1024]; hv[i] = ag[(size_t)(q + i) * 1024 + 512]; }
#pragma unroll
                for (int i = 0; i < 32; ++i) c = av[i] * c + hv[i]; }
            for (; q + 8 <= pt; q += 8) { float av[8], hv[8];
#pragma unroll
                for (int i = 0; i < 8; ++i) { av[i] = ag[(size_t)(q + i) * 1024]; hv[i] = ag[(size_t)(q + i) * 1024 + 512]; }
#pragma unroll
                for (int i = 0; i < 8; ++i) c = av[i] * c + hv[i]; }
            for (; q < pt; ++q) c = ag[(size_t)q * 1024] * c + ag[(size_t)q * 1024 + 512];
            rg_tile<true>(mp, tile, lds, wid, lane, c);
        }
        __syncthreads();
    }
}

__global__ void __launch_bounds__(512, 2) mega(Params p) {
    extern __shared__ __attribute__((aligned(16))) unsigned char lds_raw[];
    LAS unsigned char* lds = (LAS unsigned char*)lds_raw;
    cg::grid_group grid = cg::this_grid();
    if (threadIdx.x == 0) {
        LAS unsigned long long* pt = (LAS unsigned long long*)(lds + LDS_PTAB);
#define PT(i) pt[i] = (unsigned long long)p.in[i];
        PT(0) PT(1) PT(2) PT(3) PT(4) PT(5) PT(6) PT(7) PT(8) PT(9) PT(10) PT(11) PT(12) PT(13) PT(14) PT(15) PT(16) PT(17) PT(18) PT(19)
#undef PT
    }
    volatile LAS unsigned* bst = (volatile LAS unsigned*)(lds + LDS_PTAB + 256);
    if (threadIdx.x < 4) bst[threadIdx.x] = 0u;
    unsigned* barw = (unsigned*)(p.ws + WS_BAR);
    __syncthreads();
    XcdBarrier xb = xcd_barrier_post(barw, bst);
    if (p.ph_hi > 1000) grid.sync();
    for (int ph = p.ph_lo; ph < p.ph_hi; ++ph) {
        unsigned char* ws = p.ws; float* outp = p.out; int tid = threadIdx.x;
        asm volatile("" : "+s"(ws), "+s"(outp), "+v"(tid));
        bf16_t* XB = (bf16_t*)(ws + WS_XB); bf16_t* HZ = (bf16_t*)(ws + WS_HZ); bf16_t* Y = (bf16_t*)(ws + WS_Y);
#ifndef NO_PRO
        if (ph == 0) prologue_phase(ws, lds, tid);
        else
#endif
        {
            const int l = (ph - 1) / 11, q = (ph - 1) % 11;
            if (q == 2 || q == 7 || q == 10) {
                const int k = q == 2 ? 0 : (q == 7 ? 1 : 2);
#ifndef NO_LN
                ln_phase(outp, XB, (float*)(ws + WS_ST) + (size_t)(l * 3 + k) * T * 2, ph == NPHASE - 1, inptr(lds, 1) + (size_t)(l * 3 + k) * D, inptr(lds, 2) + (size_t)(l * 3 + k) * D, tid);
#endif
            } else if (q != 4 && q != 5) {
                pg8::Gemm g; EpiAny E{};
                if (q == 0 || q == 8) {
                    const int lf = l * 2 + (q == 8);
                    g = pg8::Gemm{XB, (const bf16_t*)(ws + WS_WGU + (size_t)lf * SZ_WGU), T, NGU, D}; E.mode = 0; E.O = HZ; E.ldc = FF;
                } else if (q == 3) {
                    g = pg8::Gemm{XB, (const bf16_t*)(ws + WS_WIN + (size_t)l * SZ_WIN), T, NIN, D}; E.mode = 2; E.O = HZ; E.ldc = NIN;
                } else {
                    E.mode = 1; E.res = (l == 0 && q == 1) ? inptr(lds, 0) : outp; E.out = outp;
                    const int lp = q == 1 ? 3 * l - 1 : (q == 6 ? 3 * l : 3 * l + 1);
                    if (lp >= 0) { E.St = (const float*)(ws + WS_ST) + (size_t)lp * T * 2; E.gp = inptr(lds, 1) + (size_t)lp * D; E.bp = inptr(lds, 2) + (size_t)lp * D; }
                    if (q == 6) { g = pg8::Gemm{Y, (const bf16_t*)(ws + WS_WOUT + (size_t)l * SZ_WOUT), T, D, D}; E.scale = 1.0f; }
                    else { const int lf = l * 2 + (q == 9); g = pg8::Gemm{HZ, (const bf16_t*)(ws + WS_WD + (size_t)lf * SZ_WD), T, D, FF}; E.scale = 0.5f; }
                }
                pg8::StaticOrder S; S.init(g.M, g.N, gridDim.x, blockIdx.x);
#ifndef NO_G1
                pg8::gemm_phase<EpiAny, pg8::StaticOrder>(lds, g, S, E, nullptr, tid);
#endif
            } else {
                MixP mp{HZ, Y, (float*)(ws + WS_AGG), (const bf16_t*)(ws + WS_SGUW + (size_t)l * SZ_SGUW), (const bf16_t*)(ws + WS_RGW + (size_t)l * SZ_RGW),
                        inptr(lds, 7) + l * 256, inptr(lds, 8) + l * 256, inptr(lds, 10) + l * 512, inptr(lds, 11) + l * 768, inptr(lds, 12) + l * 2048, inptr(lds, 13) + l * 512, inptr(lds, 15) + l * 512, inptr(lds, 17) + l * 512, inptr(lds, 18) + l * 512};
#ifndef NO_MIX1
                if (q == 4) mix1_phase(mp, lds, tid);
#endif
#ifndef NO_MIX2
                if (q == 5) mix2_phase(mp, lds, tid);
#endif
            }
        }
        if (ph + 1 < p.ph_hi) {
            xcd_barrier(xb);
        }
    }
}

extern "C" void kernel_launch(void* const* d_in, const int* in_sizes, int n_in, void* d_out, int out_size, void* d_ws, size_t ws_size, hipStream_t stream) {
    static int grid = 0;
    if (grid == 0) {
        if (n_in != 20 || out_size != T * D || ws_size < WS_END) { fprintf(stderr, "kernel_launch: unexpected shapes (n_in %d out %d ws %zu need %zu)\n", n_in, out_size, ws_size, (size_t)WS_END); grid = -1; return; }
        int dev = 0, cus = 0, per_cu = 0;
        hipGetDevice(&dev); hipDeviceGetAttribute(&cus, hipDeviceAttributeMultiprocessorCount, dev);
        if (hipFuncSetAttribute((const void*)mega, hipFuncAttributeMaxDynamicSharedMemorySize, LDS_BYTES) != hipSuccess) { fprintf(stderr, "kernel_launch: hipFuncSetAttribute failed\n"); grid = -1; return; }
        if (hipOccupancyMaxActiveBlocksPerMultiprocessor(&per_cu, (const void*)mega, 512, LDS_BYTES) != hipSuccess || per_cu < 1) { fprintf(stderr, "kernel_launch: occupancy query says %d\n", per_cu); per_cu = 1; }
        (void)hipGetLastError();
        grid = cus * per_cu;
    }
    if (grid < 0) return;
    Params p{};
    for (int i = 0; i < 20; ++i) p.in[i] = (const float*)d_in[i];
    p.out = (float*)d_out; p.ws = (unsigned char*)d_ws; p.ph_lo = 0; p.ph_hi = NPHASE;
    if (hipMemsetAsync((char*)d_ws + WS_BAR, 0, 16384, stream) != hipSuccess) { fprintf(stderr, "kernel_launch: memset of the barrier words failed\n"); return; }
    void* args[] = {&p};
    hipError_t e = hipLaunchCooperativeKernel((const void*)mega, dim3(grid), dim3(512), args, LDS_BYTES, stream);
    if (e != hipSuccess) fprintf(stderr, "kernel_launch: cooperative launch failed: %s (grid %d)\n", hipGetErrorString(e), grid);
}
```
